# Optimizing an MI355X kernel written in HIP

```python
import jax, jax.numpy as jnp
from jax import lax
import numpy as np

D_MODEL = 1024
BATCH = 4
SEQ = 4096
DEPTH = 1
DEC_BATCH = 8
DEC_SEQ = 64
PAST_LEN = 1024

CHUNK = 64
N_META = 16
D_RNN = 512
D_CONV = 512
N_RNN_HEADS = 8
RNN_HEAD_DIM = D_RNN // N_RNN_HEADS
RNN_CONV_W = 4
DW_CONV_W = 31
D_FF = 4 * D_MODEL
RGLRU_C = 8.0
EPS = 1e-6
D_IN = 2 * D_RNN + 2 * D_CONV

kernel_name = "hymba_griffin_conformer_stream_step"


def _rmsnorm(x, g):
    xf = x.astype(jnp.float32)
    y = xf * lax.rsqrt(jnp.mean(xf * xf, axis=-1, keepdims=True) + EPS)
    return (y * g.astype(jnp.float32)).astype(x.dtype)


def _layernorm(x, g, b):
    xf = x.astype(jnp.float32)
    mu = jnp.mean(xf, axis=-1, keepdims=True)
    xc = xf - mu
    y = xc * lax.rsqrt(jnp.mean(xc * xc, axis=-1, keepdims=True) + EPS)
    return (y * g.astype(jnp.float32) + b.astype(jnp.float32)).astype(x.dtype)


def _causal_dwconv(x, state, w, b):
    xpad = jnp.concatenate([state.astype(x.dtype), x], axis=1)
    out = lax.conv_general_dilated(
        xpad, w[:, None, :].astype(x.dtype), window_strides=(1,), padding="VALID",
        dimension_numbers=("NWC", "WIO", "NWC"), feature_group_count=x.shape[-1])
    return out + b.astype(x.dtype), xpad[:, -(w.shape[0] - 1):]


def _rglru(x, h0, w_r, b_r, w_i, b_i, lam):
    B, T, C = x.shape
    xf = x.astype(jnp.float32)
    xh = xf.reshape(B, T, N_RNN_HEADS, RNN_HEAD_DIM)
    r = jax.nn.sigmoid(jnp.einsum("bthd,hde->bthe", xh, w_r.astype(jnp.float32)).reshape(B, T, C)
                       + b_r.astype(jnp.float32))
    i = jax.nn.sigmoid(jnp.einsum("bthd,hde->bthe", xh, w_i.astype(jnp.float32)).reshape(B, T, C)
                       + b_i.astype(jnp.float32))
    log_a = -RGLRU_C * r * jax.nn.softplus(-lam.astype(jnp.float32))
    a = jnp.exp(log_a)
    mult = jnp.sqrt(jnp.maximum(-jnp.expm1(2.0 * log_a), 0.0))
    b_in = mult * i * xf

    def step(h, ab):
        a_t, b_t = ab
        h = a_t * h + b_t
        return h, h

    hT, hs = lax.scan(step, h0.astype(jnp.float32),
                      (jnp.swapaxes(a, 0, 1), jnp.swapaxes(b_in, 0, 1)))
    return jnp.swapaxes(hs, 0, 1).astype(x.dtype), hT.astype(h0.dtype)


def _layer(x, conv_state, h_state, dw_state, norm_mix, w_in, rnn_conv_w, rnn_conv_b,
           w_gate_r, b_gate_r, w_gate_i, b_gate_i, rglru_lambda, dw_w, dw_b, ln_conv_g,
           ln_conv_b, out_norm_rnn, out_norm_conv, w_out, norm_mlp, w_up, w_down):
    hn = _rmsnorm(x, norm_mix)
    z = hn @ w_in
    xr, gate, glu_v, glu_g = jnp.split(z, [D_RNN, 2 * D_RNN, 2 * D_RNN + D_CONV], axis=-1)
    xr_c, new_conv = _causal_dwconv(xr, conv_state, rnn_conv_w, rnn_conv_b)
    hr, new_h = _rglru(xr_c, h_state, w_gate_r, b_gate_r, w_gate_i, b_gate_i, rglru_lambda)
    y_rnn = hr * jax.nn.gelu(gate)
    v = glu_v * jax.nn.sigmoid(glu_g)
    vc, new_dw = _causal_dwconv(v, dw_state, dw_w, dw_b)
    y_conv = jax.nn.silu(_layernorm(vc, ln_conv_g, ln_conv_b))
    mix = jnp.concatenate([_rmsnorm(y_rnn, out_norm_rnn), _rmsnorm(y_conv, out_norm_conv)], axis=-1)
    x = x + mix @ w_out
    hm = _rmsnorm(x, norm_mlp)
    x = x + jnp.square(jax.nn.relu(hm @ w_up)) @ w_down
    return x, new_conv, new_h, new_dw


def setup_inputs(seed: int = 0) -> dict:
    key = jax.random.key(seed)
    ks = jax.random.split(key, 32)
    nrm = jax.random.normal
    f32 = jnp.float32
    u = jax.random.uniform(ks[10], (DEPTH, D_RNN), f32, 0.9, 0.999)
    a_base = u ** (1.0 / RGLRU_C)
    lam = jnp.log(a_base) - jnp.log1p(-a_base)
    return {
        "x_prompt": nrm(ks[0], (BATCH, SEQ, D_MODEL), f32),
        "x_sample": nrm(ks[1], (DEC_BATCH, DEC_SEQ, D_MODEL), f32),
        "state_rglru_conv": nrm(ks[2], (DEPTH, DEC_BATCH, RNN_CONV_W - 1, D_RNN), f32),
        "state_rglru_h": 0.5 * nrm(ks[3], (DEPTH, DEC_BATCH, D_RNN), f32),
        "state_dwconv": 0.5 * nrm(ks[4], (DEPTH, DEC_BATCH, DW_CONV_W - 1, D_CONV), f32),
        "meta_tokens": nrm(ks[5], (N_META, D_MODEL), f32),
        "norm_mix": 1.0 + 0.05 * nrm(ks[6], (DEPTH, D_MODEL), f32),
        "w_in": nrm(ks[7], (DEPTH, D_MODEL, D_IN), f32) * D_MODEL ** -0.5,
        "rnn_conv_w": nrm(ks[8], (DEPTH, RNN_CONV_W, D_RNN), f32) * RNN_CONV_W ** -0.5,
        "rnn_conv_b": 0.01 * nrm(ks[9], (DEPTH, D_RNN), f32),
        "w_gate_r": nrm(ks[11], (DEPTH, N_RNN_HEADS, RNN_HEAD_DIM, RNN_HEAD_DIM), f32) * RNN_HEAD_DIM ** -0.5,
        "b_gate_r": 0.01 * nrm(ks[12], (DEPTH, D_RNN), f32),
        "w_gate_i": nrm(ks[13], (DEPTH, N_RNN_HEADS, RNN_HEAD_DIM, RNN_HEAD_DIM), f32) * RNN_HEAD_DIM ** -0.5,
        "b_gate_i": 0.01 * nrm(ks[14], (DEPTH, D_RNN), f32),
        "rglru_lambda": lam,
        "dw_w": nrm(ks[15], (DEPTH, DW_CONV_W, D_CONV), f32) * DW_CONV_W ** -0.5,
        "dw_b": 0.01 * nrm(ks[16], (DEPTH, D_CONV), f32),
        "ln_conv_g": 1.0 + 0.05 * nrm(ks[17], (DEPTH, D_CONV), f32),
        "ln_conv_b": 0.01 * nrm(ks[18], (DEPTH, D_CONV), f32),
        "out_norm_rnn": 1.0 + 0.05 * nrm(ks[19], (DEPTH, D_RNN), f32),
        "out_norm_conv": 1.0 + 0.05 * nrm(ks[20], (DEPTH, D_CONV), f32),
        "w_out": nrm(ks[21], (DEPTH, D_RNN + D_CONV, D_MODEL), f32) * (D_RNN + D_CONV) ** -0.5,
        "norm_mlp": 1.0 + 0.05 * nrm(ks[22], (DEPTH, D_MODEL), f32),
        "w_up": nrm(ks[23], (DEPTH, D_MODEL, D_FF), f32) * D_MODEL ** -0.5,
        "w_down": nrm(ks[24], (DEPTH, D_FF, D_MODEL), f32) * D_FF ** -0.5,
        "norm_final": 1.0 + 0.05 * nrm(ks[25], (D_MODEL,), f32),
    }


def reference(x_prompt, x_sample, state_rglru_conv, state_rglru_h, state_dwconv, meta_tokens,
              norm_mix, w_in, rnn_conv_w, rnn_conv_b, w_gate_r, b_gate_r, w_gate_i, b_gate_i,
              rglru_lambda, dw_w, dw_b, ln_conv_g, ln_conv_b, out_norm_rnn, out_norm_conv,
              w_out, norm_mlp, w_up, w_down, norm_final):
    bp = x_prompt.shape[0]
    dt = x_prompt.dtype
    meta = jnp.broadcast_to(meta_tokens.astype(dt)[None], (bp, N_META, D_MODEL))
    xp = jnp.concatenate([meta, x_prompt], axis=1)
    xs = x_sample
    conv_p, h_p, dw_p, conv_s, h_s, dw_s = [], [], [], [], [], []
    for l in range(DEPTH):
        params = (norm_mix[l], w_in[l], rnn_conv_w[l], rnn_conv_b[l], w_gate_r[l], b_gate_r[l],
                  w_gate_i[l], b_gate_i[l], rglru_lambda[l], dw_w[l], dw_b[l], ln_conv_g[l],
                  ln_conv_b[l], out_norm_rnn[l], out_norm_conv[l], w_out[l], norm_mlp[l],
                  w_up[l], w_down[l])
        xp, c_p, hh_p, d_p = _layer(
            xp, jnp.zeros((bp, RNN_CONV_W - 1, D_RNN), dt), jnp.zeros((bp, D_RNN), dt),
            jnp.zeros((bp, DW_CONV_W - 1, D_CONV), dt), *params)
        xs, c_s, hh_s, d_s = _layer(xs, state_rglru_conv[l], state_rglru_h[l], state_dwconv[l], *params)
        conv_p.append(c_p); h_p.append(hh_p); dw_p.append(d_p)
        conv_s.append(c_s); h_s.append(hh_s); dw_s.append(d_s)
    y_prompt = _rmsnorm(xp, norm_final)[:, N_META:]
    y_sample = _rmsnorm(xs, norm_final)
    new_rglru_conv_prompt = jnp.stack(conv_p)
    new_rglru_h_prompt = jnp.stack(h_p)
    new_dwconv_prompt = jnp.stack(dw_p)
    new_rglru_conv_sample = jnp.stack(conv_s)
    new_rglru_h_sample = jnp.stack(h_s)
    new_dwconv_sample = jnp.stack(dw_s)
    return (y_prompt, y_sample, new_rglru_conv_prompt, new_rglru_h_prompt, new_dwconv_prompt,
            new_rglru_conv_sample, new_rglru_h_sample, new_dwconv_sample)
```

```cpp
#include <hip/hip_runtime.h>
#include <cstdio>
#include <cstdint>
#include <cmath>
namespace pg8 {
#define PG8_LAS __attribute__((address_space(3)))
typedef unsigned short bf16_t;
typedef short bf16x8 __attribute__((ext_vector_type(8)));
typedef float f32x4 __attribute__((ext_vector_type(4)));
typedef unsigned u32x4 __attribute__((ext_vector_type(4)));
constexpr int BM = 256, BK = 64, HALF = 128, HTB = HALF * BK * 2  , STAGE_BYTES = 8 * HTB, NXCD = 8, WGM = 8;

__host__ __device__ __forceinline__ int lds_byte(int r, int c) { const int st = (r >> 4) * 2 + (c >> 5), rr = r & 15, cc = c & 31, ob = rr * 64 + cc * 2; return st * 1024 + (ob ^ (((ob >> 9) & 1) << 5)); }
__host__ __device__ __forceinline__ void stage_rc(int b, int& R, int& C) { const int st = b / 1024, sb = b % 1024, swz = sb ^ (((sb >> 9) & 1) << 5); R = (st >> 1) * 16 + swz / 64; C = (st & 1) * 32 + (swz % 64) / 2; }
__host__ __device__ __forceinline__ int perm32(int rho) { const int n = rho >> 4, i = rho & 15; return 8 * (i >> 2) + 4 * n + (i & 3); }

struct Unit { int pm, pn; };
struct Gemm { const bf16_t* A; const bf16_t* Bt; int M, N, K; };

struct StaticOrder {
    int nM, nN, nwg, G, c;
    __host__ __device__ void init(int M, int N, int G_, int c_) { nM = M / BM; nN = N / BM; nwg = nM * nN; G = G_; c = c_; }
    __host__ __device__ bool next(int i, Unit& u) const {
        const long L = (long)i * G + c; if (L >= nwg) return false;
        int wgid = (int)L; { const int q = nwg / NXCD, r = nwg % NXCD, xcd = wgid % NXCD, off = wgid / NXCD; wgid = (xcd < r ? xcd * (q + 1) : r * (q + 1) + (xcd - r) * q) + off; }
        const int nig = WGM * nN, gid = wgid / nig, fm = gid * WGM, gsz = (nM - fm) < WGM ? (nM - fm) : WGM;
        u.pm = fm + ((wgid % nig) % gsz); u.pn = (wgid % nig) / gsz; return true;
    }
    __device__ __forceinline__ void a_ready(const Unit&) const {}
    __device__ __forceinline__ void done(const Unit&) const {}
};

__device__ __forceinline__ unsigned cvt_pk_bf16(float lo, float hi) { unsigned r; asm volatile("v_cvt_pk_bf16_f32 %0, %1, %2" : "=v"(r) : "v"(lo), "v"(hi)); return r; }
typedef float f32x2 __attribute__((ext_vector_type(2)));
__device__ __forceinline__ float fast_sigmoid(float x) { return __builtin_amdgcn_rcpf(1.0f + __builtin_amdgcn_exp2f(-1.4426950408889634f * x)); }
__device__ __forceinline__ float gelu_tanh(float x) {
    const float t = x * (1.0f + 0.044715f * x * x);
    return x * __builtin_amdgcn_rcpf(1.0f + __builtin_amdgcn_exp2f(-2.3022081985f * t));
}
constexpr int ZC = 512;
struct EpiZ {
    static constexpr bool PERM = true, AFTER_DRAIN = false;
    bf16_t *XR, *GG, *V;
    __device__ __forceinline__ void operator()(const f32x4 (&acc)[2][2][4][2], const Unit& u, int wr, int wc, int fr, int fq) const {
        const int row0 = u.pm * BM + wr * 64 + fr, cw = wc * 32 + 8 * fq;
        if (u.pn < 4) {
            bf16_t* base = (u.pn < 2 ? XR : GG) + (u.pn & 1) * 256 + cw; const bool act = u.pn >= 2;
#pragma unroll
            for (int ai = 0; ai < 2; ++ai)
#pragma unroll
                for (int m = 0; m < 4; ++m) { bf16_t* rowp = base + (size_t)(row0 + ai * HALF + m * 16) * ZC;
#pragma unroll
                    for (int bj = 0; bj < 2; ++bj) { f32x4 v0 = acc[ai][bj][m][0], v1 = acc[ai][bj][m][1];
                        if (act) {
#pragma unroll
                            for (int j = 0; j < 4; ++j) { v0[j] = gelu_tanh(v0[j]); v1[j] = gelu_tanh(v1[j]); } }
                        u32x4 w; w.x = cvt_pk_bf16(v0[0], v0[1]); w.y = cvt_pk_bf16(v0[2], v0[3]); w.z = cvt_pk_bf16(v1[0], v1[1]); w.w = cvt_pk_bf16(v1[2], v1[3]);
                        *(u32x4*)(rowp + bj * HALF) = w; } }
        } else {
            bf16_t* base = V + (u.pn - 4) * 128 + cw;
#pragma unroll
            for (int ai = 0; ai < 2; ++ai)
#pragma unroll
                for (int m = 0; m < 4; ++m) { bf16_t* rowp = base + (size_t)(row0 + ai * HALF + m * 16) * ZC;
                    f32x4 v0 = acc[ai][0][m][0], v1 = acc[ai][0][m][1]; const f32x4 g0 = acc[ai][1][m][0], g1 = acc[ai][1][m][1];
#pragma unroll
                    for (int j = 0; j < 4; ++j) { v0[j] *= fast_sigmoid(g0[j]); v1[j] *= fast_sigmoid(g1[j]); }
                    u32x4 w; w.x = cvt_pk_bf16(v0[0], v0[1]); w.y = cvt_pk_bf16(v0[2], v0[3]); w.z = cvt_pk_bf16(v1[0], v1[1]); w.w = cvt_pk_bf16(v1[2], v1[3]);
                    *(u32x4*)rowp = w; }
        }
    }
};
typedef unsigned u32x2 __attribute__((ext_vector_type(2)));
template <bool WITH_BF16> struct EpiRes {
    static constexpr bool PERM = false, AFTER_DRAIN = false;
    const float* xa; const float* xb; int pm_split;
    float* X1; bf16_t* X1B; float* SSQ;
    __device__ __forceinline__ void operator()(const f32x4 (&acc)[2][2][4][2], const Unit& u, int wr, int wc, int fr, int fq) const {
        const float* xin = (u.pm < pm_split) ? xa + (size_t)u.pm * BM * 1024 : xb + (size_t)(u.pm - pm_split) * BM * 1024;
        const int col0 = u.pn * BM + wc * 32 + 4 * fq;
#pragma unroll
        for (int ai = 0; ai < 2; ++ai)
#pragma unroll
            for (int m = 0; m < 4; ++m) { const int rl = ai * HALF + wr * 64 + m * 16 + fr; const size_t R = (size_t)u.pm * BM + rl; float s = 0.f;
#pragma unroll
                for (int bj = 0; bj < 2; ++bj)
#pragma unroll
                    for (int n = 0; n < 2; ++n) { const int off = col0 + bj * HALF + n * 16; const f32x4 xv = *(const f32x4*)(xin + (size_t)rl * 1024 + off); const f32x4 o = xv + acc[ai][bj][m][n];
                        *(f32x4*)(X1 + R * 1024 + off) = o; s += (o[0] * o[0] + o[1] * o[1]) + (o[2] * o[2] + o[3] * o[3]);
                        if (WITH_BF16) { u32x2 w; w.x = cvt_pk_bf16(o[0], o[1]); w.y = cvt_pk_bf16(o[2], o[3]); *(u32x2*)(X1B + R * 1024 + off) = w; } }
                s += __shfl_xor(s, 16); s += __shfl_xor(s, 32);
                if (fq == 0) SSQ[R * 16 + u.pn * 4 + wc] = s;
                asm volatile("" ::: "memory"); }
    }
};
struct EpiU {
    static constexpr bool PERM = true, AFTER_DRAIN = false;
    const float* SSQ; bf16_t* U; int ldc;
    __device__ __forceinline__ void operator()(const f32x4 (&acc)[2][2][4][2], const Unit& u, int wr, int wc, int fr, int fq) const {
        const int row0 = u.pm * BM + wr * 64 + fr, col0 = u.pn * BM + wc * 32 + 8 * fq;
#pragma unroll
        for (int ai = 0; ai < 2; ++ai)
#pragma unroll
            for (int m = 0; m < 4; ++m) { const size_t R = (size_t)(row0 + ai * HALF + m * 16);
                const f32x4 p0 = *(const f32x4*)(SSQ + R * 16), p1 = *(const f32x4*)(SSQ + R * 16 + 4), p2 = *(const f32x4*)(SSQ + R * 16 + 8), p3 = *(const f32x4*)(SSQ + R * 16 + 12);
                const f32x4 ps = (p0 + p1) + (p2 + p3); const float rinv = __builtin_amdgcn_rsqf(((ps[0] + ps[1]) + (ps[2] + ps[3])) * (1.0f / 1024.0f) + 1e-6f);
                bf16_t* rowp = U + R * ldc + col0;
#pragma unroll
                for (int bj = 0; bj < 2; ++bj) { f32x4 v0 = acc[ai][bj][m][0] * rinv, v1 = acc[ai][bj][m][1] * rinv;
#pragma unroll
                    for (int j = 0; j < 4; ++j) { const float a = fmaxf(v0[j], 0.f), b = fmaxf(v1[j], 0.f); v0[j] = a * a; v1[j] = b * b; }
                    u32x4 w; w.x = cvt_pk_bf16(v0[0], v0[1]); w.y = cvt_pk_bf16(v0[2], v0[3]); w.z = cvt_pk_bf16(v1[0], v1[1]); w.w = cvt_pk_bf16(v1[2], v1[3]);
                    *(u32x4*)(rowp + bj * HALF) = w; } }
    }
};
template <class Epi, class Sched, bool ALIGN_EPI = false, bool SP2 = false>
__device__ __forceinline__ void gemm_phase(PG8_LAS unsigned char* lds, const Gemm g, const Sched& S, const Epi& E) {
    const int tid = threadIdx.x, wid = __builtin_amdgcn_readfirstlane(tid >> 6), lane = tid & 63, wr = wid >> 2, wc = wid & 3, fr = lane & 15, fq = lane >> 4;
    const int K = g.K, nt = K / BK;
    unsigned voffA[2], voffB[2];
#pragma unroll
    for (int i = 0; i < 2; ++i) { int R, C; stage_rc(tid * 16 + i * 8192, R, C); const int Rb = Epi::PERM ? ((R & ~31) + perm32(R & 31)) : R;
        voffA[i] = (unsigned)(R * K + C) * 2u; voffB[i] = (unsigned)(Rb * K + C) * 2u; }
    const size_t kstep = (size_t)(BK * 2);
    const size_t hstep = (size_t)HALF * K * 2;
    const size_t tstep = 2 * hstep;
    const unsigned ldsw = (unsigned)wid * 1024u;
    const int aoff = lds_byte(wr * 64 + fr, fq * 8), boff = lds_byte(wc * 32 + fr, fq * 8);
#define PG8_SA(b, h) (((b) * 2 + (h)) * HTB)
#define PG8_SB(b, h) ((4 + (b) * 2 + (h)) * HTB)
#define PG8_STAGE(bufoff, gbase, voff) do { _Pragma("unroll") for (int _i = 0; _i < 2; ++_i) \
        __builtin_amdgcn_global_load_lds((const unsigned*)((const char*)(gbase) + (voff)[_i]), (PG8_LAS unsigned*)(lds + (bufoff) + ldsw + _i * 8192), 16, 0, 0); } while (0)
#define PG8_LDA(dst, b, h) do { _Pragma("unroll") for (int m = 0; m < 4; ++m) _Pragma("unroll") for (int k = 0; k < 2; ++k) dst[m][k] = *(const PG8_LAS bf16x8*)(lds + PG8_SA(b, h) + aoff + m * 2048 + k * 1024); } while (0)
#define PG8_LDB(dst, b, h) do { _Pragma("unroll") for (int n = 0; n < 2; ++n) _Pragma("unroll") for (int k = 0; k < 2; ++k) dst[n][k] = *(const PG8_LAS bf16x8*)(lds + PG8_SB(b, h) + boff + n * 2048 + k * 1024); } while (0)
#define PG8_MMA(ai, bj, At, Bt) do { __builtin_amdgcn_s_setprio(1); _Pragma("unroll") for (int m = 0; m < 4; ++m) _Pragma("unroll") for (int n = 0; n < 2; ++n) _Pragma("unroll") for (int k = 0; k < 2; ++k) \
        acc[ai][bj][m][n] = __builtin_amdgcn_mfma_f32_16x16x32_bf16(Bt[n][k], At[m][k], acc[ai][bj][m][n], 0, 0, 0); __builtin_amdgcn_s_setprio(0); } while (0)
#define PG8_WAIT_V(n) asm volatile("s_waitcnt vmcnt(" #n ")" ::: "memory")
#define PG8_WAIT_L(n) asm volatile("s_waitcnt lgkmcnt(" #n ")" ::: "memory")
#define PG8_BAR __builtin_amdgcn_s_barrier()
#define PG8_SCHED __builtin_amdgcn_sched_barrier(0)
    Unit cur, nxt; int ui = 0;
    if (!S.next(0, cur)) return;
    f32x4 acc[2][2][4][2];
#pragma unroll
    for (int a = 0; a < 2; ++a)
#pragma unroll
        for (int b = 0; b < 2; ++b)
#pragma unroll
            for (int m = 0; m < 4; ++m)
#pragma unroll
                for (int n = 0; n < 2; ++n) acc[a][b][m][n] = (f32x4){0.f, 0.f, 0.f, 0.f};
    bf16x8 At[4][2], B0[2][2], B1[2][2];
    const char* cA = (const char*)g.A + (size_t)cur.pm * tstep; const char* cB = (const char*)g.Bt + (size_t)cur.pn * tstep;
    S.a_ready(cur);
    if constexpr (SP2) {
        PG8_STAGE(PG8_SB(0, 0), cB, voffB); PG8_STAGE(PG8_SB(0, 1), cB + hstep, voffB); PG8_STAGE(PG8_SA(0, 0), cA, voffA); PG8_STAGE(PG8_SA(0, 1), cA + hstep, voffA);
        if (wr == 1) PG8_BAR;
        PG8_WAIT_V(2); PG8_BAR;
        PG8_STAGE(PG8_SB(1, 0), cB + kstep, voffB); PG8_STAGE(PG8_SA(1, 0), cA + kstep, voffA); PG8_STAGE(PG8_SB(1, 1), cB + hstep + kstep, voffB);
        PG8_WAIT_V(6); PG8_BAR;
    } else {
        PG8_STAGE(PG8_SB(0, 0), cB, voffB); PG8_STAGE(PG8_SA(0, 0), cA, voffA); PG8_STAGE(PG8_SB(0, 1), cB + hstep, voffB); PG8_STAGE(PG8_SA(0, 1), cA + hstep, voffA);
        if (wr == 1) PG8_BAR;
        PG8_WAIT_V(4); PG8_BAR;
        PG8_STAGE(PG8_SB(1, 0), cB + kstep, voffB); PG8_STAGE(PG8_SA(1, 0), cA + kstep, voffA); PG8_STAGE(PG8_SB(1, 1), cB + hstep + kstep, voffB);
        PG8_WAIT_V(6); PG8_BAR;
    }
    for (;;) {
        const bool has_next = S.next(ui + 1, nxt);
        const char* nA = has_next ? (const char*)g.A + (size_t)nxt.pm * tstep : cA; const char* nB = has_next ? (const char*)g.Bt + (size_t)nxt.pn * tstep : cB;
        for (int t = 0; t < nt; t += 2) {
            const bool last = (t == nt - 2);
            const char* a1 = cA + (size_t)(t + 1) * kstep;
            const char* a2 = last ? nA : cA + (size_t)(t + 2) * kstep; const char* b2 = last ? nB : cB + (size_t)(t + 2) * kstep;
            const char* a3 = a2 + kstep; const char* b3 = b2 + kstep;
            if (last && has_next) S.a_ready(nxt);
            if constexpr (SP2) {
            PG8_LDB(B0, 0, 0); PG8_LDB(B1, 0, 1); PG8_SCHED; PG8_LDA(At, 0, 0); PG8_STAGE(PG8_SA(1, 1), a1 + hstep, voffA);
            PG8_WAIT_V(8); PG8_WAIT_L(0); PG8_BAR; PG8_MMA(0, 0, At, B0); PG8_MMA(0, 1, At, B1); PG8_BAR; PG8_SCHED;
            PG8_LDA(At, 0, 1); PG8_STAGE(PG8_SB(0, 0), b2, voffB); PG8_STAGE(PG8_SB(0, 1), b2 + hstep, voffB); PG8_STAGE(PG8_SA(0, 0), a2, voffA);
            PG8_WAIT_V(8); PG8_WAIT_L(0); PG8_BAR; PG8_MMA(1, 0, At, B0); PG8_MMA(1, 1, At, B1); PG8_BAR; PG8_SCHED;
            PG8_LDB(B0, 1, 0); PG8_LDB(B1, 1, 1); PG8_SCHED; PG8_LDA(At, 1, 0); PG8_STAGE(PG8_SA(0, 1), a2 + hstep, voffA);
            PG8_WAIT_V(8); PG8_WAIT_L(0); PG8_BAR; PG8_MMA(0, 0, At, B0); PG8_MMA(0, 1, At, B1); PG8_BAR; PG8_SCHED;
            PG8_LDA(At, 1, 1); PG8_STAGE(PG8_SB(1, 0), b3, voffB); PG8_STAGE(PG8_SB(1, 1), b3 + hstep, voffB); PG8_STAGE(PG8_SA(1, 0), a3, voffA);
            PG8_WAIT_V(8); PG8_WAIT_L(0); PG8_BAR; PG8_MMA(1, 0, At, B0); PG8_MMA(1, 1, At, B1); PG8_BAR; PG8_SCHED;
            } else {
            PG8_LDB(B0, 0, 0); PG8_SCHED; PG8_LDA(At, 0, 0); PG8_STAGE(PG8_SA(1, 1), a1 + hstep, voffA);
            PG8_WAIT_L(8); PG8_BAR; PG8_WAIT_L(0); PG8_MMA(0, 0, At, B0); PG8_BAR; PG8_SCHED;
            PG8_LDB(B1, 0, 1); PG8_STAGE(PG8_SB(0, 0), b2, voffB);
            PG8_BAR; PG8_WAIT_L(0); PG8_MMA(0, 1, At, B1); PG8_BAR;
            PG8_LDA(At, 0, 1); PG8_STAGE(PG8_SA(0, 0), a2, voffA);
            PG8_BAR; PG8_WAIT_L(0); PG8_MMA(1, 0, At, B0); PG8_BAR; PG8_SCHED;
            PG8_STAGE(PG8_SB(0, 1), b2 + hstep, voffB);
            PG8_WAIT_V(6); PG8_BAR; PG8_MMA(1, 1, At, B1); PG8_BAR;
            PG8_LDB(B0, 1, 0); PG8_SCHED; PG8_LDA(At, 1, 0); PG8_STAGE(PG8_SA(0, 1), a2 + hstep, voffA);
            PG8_WAIT_L(8); PG8_BAR; PG8_WAIT_L(0); PG8_MMA(0, 0, At, B0); PG8_BAR; PG8_SCHED;
            PG8_LDB(B1, 1, 1); PG8_STAGE(PG8_SB(1, 0), b3, voffB);
            PG8_BAR; PG8_WAIT_L(0); PG8_MMA(0, 1, At, B1); PG8_BAR;
            PG8_LDA(At, 1, 1); PG8_STAGE(PG8_SA(1, 0), a3, voffA);
            PG8_BAR; PG8_WAIT_L(0); PG8_MMA(1, 0, At, B0); PG8_BAR; PG8_SCHED;
            PG8_STAGE(PG8_SB(1, 1), b3 + hstep, voffB);
            PG8_WAIT_V(6); PG8_BAR; PG8_MMA(1, 1, At, B1); PG8_BAR;
            }
        }
        if constexpr (ALIGN_EPI) { if (wr == 0) PG8_BAR; }
        if constexpr (!Epi::AFTER_DRAIN) { E(acc, cur, wr, wc, fr, fq); S.done(cur); }
        if (!has_next) break;
#pragma unroll
        for (int a = 0; a < 2; ++a)
#pragma unroll
            for (int b = 0; b < 2; ++b)
#pragma unroll
                for (int m = 0; m < 4; ++m)
#pragma unroll
                    for (int n = 0; n < 2; ++n) acc[a][b][m][n] = (f32x4){0.f, 0.f, 0.f, 0.f};
        cur = nxt; cA = nA; cB = nB; ++ui;
        if constexpr (ALIGN_EPI) { if (wr == 1) PG8_BAR; }
    }
    PG8_WAIT_V(0);
    if constexpr (!ALIGN_EPI) { if (wr == 0) PG8_BAR; }
    PG8_BAR;
    if constexpr (Epi::AFTER_DRAIN) { E.fused(acc, cur, wr, wc, fr, fq, lds, wid, lane); S.done(cur); }
#undef PG8_SA
#undef PG8_SB
#undef PG8_STAGE
#undef PG8_LDA
#undef PG8_LDB
#undef PG8_MMA
#undef PG8_WAIT_V
#undef PG8_WAIT_L
#undef PG8_BAR
#undef PG8_SCHED
}
}
#define GAS __attribute__((address_space(1)))
#define LAS __attribute__((address_space(3)))
typedef unsigned short bf16;
typedef unsigned v4u __attribute__((ext_vector_type(4)));
typedef float f32x4 __attribute__((ext_vector_type(4)));
typedef short bf16x8 __attribute__((ext_vector_type(8)));
typedef GAS unsigned gu32;
typedef GAS unsigned long long gu64;
#define RLX_AGENT __ATOMIC_RELAXED, __HIP_MEMORY_SCOPE_AGENT
#define LDS_WAIT() asm volatile("s_waitcnt lgkmcnt(0)" ::: "memory")
#define VM_WAIT() asm volatile("s_waitcnt vmcnt(0)" ::: "memory")
__device__ __forceinline__ unsigned long long rt() { return __builtin_amdgcn_s_memrealtime(); }
__device__ __forceinline__ unsigned f2bf(float f) { unsigned u = __builtin_bit_cast(unsigned, f); return (u + 0x7fffu + ((u >> 16) & 1u)) >> 16; }
__device__ __forceinline__ unsigned pk2(float lo, float hi) { return f2bf(lo) | (f2bf(hi) << 16); }
#define XB_TMO      128
#define XB_XCNT(j)  (256  + 64 * (j))
#define XB_XSUB(j)  (1280 + 64 * (j))
#define XB_XGEN(j)  (2304 + 64 * (j))
#define XB_TOP      3328
#define XB_TOPGEN   3392
#define XCD_BAR_WORDS 3456
#define XB_SPIN_CAP (1u << 18)

__device__ __forceinline__ unsigned xb_ld(unsigned* p)              { return __hip_atomic_load(p, __ATOMIC_RELAXED, __HIP_MEMORY_SCOPE_AGENT); }
__device__ __forceinline__ unsigned xb_add(unsigned* p, unsigned v) { return __hip_atomic_fetch_add(p, v, __ATOMIC_RELAXED, __HIP_MEMORY_SCOPE_AGENT); }
__device__ __forceinline__ unsigned xb_xcc_id() { return (unsigned)__builtin_amdgcn_s_getreg((3 << 11) | 20) & 0xFu; }
#define XB_SPIN(cond, bar) do { unsigned _sp = 0; while (cond) { __builtin_amdgcn_s_sleep(1); \
    if ((++_sp & 255u) == 0u) { if (xb_ld(&(bar)[XB_TMO])) break; if (_sp > XB_SPIN_CAP) { atomicAdd(&(bar)[XB_TMO], 1u); break; } } } } while (0)

struct XcdBarrier {
    unsigned* bar; unsigned x;
    volatile LAS unsigned* st;
};

__device__ __forceinline__ XcdBarrier xcd_barrier_post(unsigned* bar, volatile LAS unsigned* st) {
    XcdBarrier b; b.bar = bar; b.x = xb_xcc_id(); b.st = st;
    if (threadIdx.x == 0) (void)xb_add(&bar[XB_XCNT(b.x)], 1u);
    return b;
}
__device__ __forceinline__ void xcd_barrier_complete(unsigned* bar, unsigned x, unsigned& nloc, unsigned& nx) {
    const unsigned G = gridDim.x * gridDim.y * gridDim.z;
    unsigned sum, cnt, mine, sp = 0u;
    for (;;) {
        sum = 0u; cnt = 0u; mine = 0u;
#pragma unroll
        for (unsigned j = 0; j < 16; ++j) { const unsigned c = xb_ld(&bar[XB_XCNT(j)]); sum += c; cnt += (c > 0u) ? 1u : 0u; mine = (j == x) ? c : mine; }
        if (sum == G) break;
        __builtin_amdgcn_s_sleep(1);
        if ((++sp & 255u) == 0u) { if (xb_ld(&bar[XB_TMO])) break; if (sp > XB_SPIN_CAP) { atomicAdd(&bar[XB_TMO], 1u); break; } }
    }
    nloc = mine > 0u ? mine : 1u; nx = cnt > 0u ? cnt : 1u;
}

__device__ __forceinline__ void xcd_barrier(const XcdBarrier& b) {
    asm volatile("s_waitcnt vmcnt(0)" ::: "memory");
    __syncthreads();
    if (threadIdx.x == 0) {
        unsigned* bar = b.bar;
        __builtin_amdgcn_s_waitcnt(0);
        unsigned nloc = b.st[0], nx = b.st[1];
        if (nloc == 0u) { xcd_barrier_complete(bar, b.x, nloc, nx); b.st[0] = nloc; b.st[1] = nx; }
        const unsigned old = xb_add(&bar[XB_XSUB(b.x)], 1u);
        const unsigned gen = old / nloc;
        if (old + 1u == (gen + 1u) * nloc) {
            __builtin_amdgcn_fence(__ATOMIC_RELEASE, "agent");
            asm volatile("s_waitcnt vmcnt(0)" ::: "memory");
            const unsigned og = xb_add(&bar[XB_TOP], 1u);
            const unsigned tg = og / nx;
            if (og + 1u == (tg + 1u) * nx) xb_add(&bar[XB_TOPGEN], 1u);
            else XB_SPIN(xb_ld(&bar[XB_TOPGEN]) == tg, bar);
            __builtin_amdgcn_fence(__ATOMIC_ACQUIRE, "agent");
            xb_add(&bar[XB_XGEN(b.x)], 1u);
            asm volatile("s_waitcnt vmcnt(0)" ::: "memory");
        } else {
            XB_SPIN(xb_ld(&bar[XB_XGEN(b.x)]) == gen, bar);
            __builtin_amdgcn_fence(__ATOMIC_ACQUIRE, "agent");
            asm volatile("s_waitcnt vmcnt(0)" ::: "memory");
        }
    }
    __syncthreads();
}
constexpr int NWAVES = 8;
constexpr int D = 1024, DIN = 2048, DR = 512, DC = 512, FF = 4096, NH = 8, HD = 64;
constexpr int NB = 4, SEQ = 4096, NMETA = 16, SB = 8, SS = 64;
constexpr int M_PROMPT = NB * SEQ;
constexpr int M_SAMPLE = SB * SS;
constexpr int M_MAIN = M_PROMPT + M_SAMPLE;
constexpr int ROW_META = M_MAIN;
constexpr int M_Z = 67 * 256;
constexpr float EPS = 1e-6f;
constexpr int ZCOLS = 512;
constexpr size_t O_Y = 0;
constexpr size_t O_CONV_P = (size_t)M_MAIN * D;
constexpr size_t O_H_P = O_CONV_P + NB * 3 * DR;
constexpr size_t O_DW_P = O_H_P + NB * DR;
constexpr size_t O_CONV_S = O_DW_P + NB * 30 * DC;
constexpr size_t O_H_S = O_CONV_S + SB * 3 * DR;
constexpr size_t O_DW_S = O_H_S + SB * DR;
constexpr size_t O_END = O_DW_S + SB * 30 * DC;
static_assert(O_END == 17510400, "d_out size");
constexpr size_t MiB = 1u << 20;
constexpr size_t WS_CTL = 0, CTL_ZERO_BYTES = 64 * 1024;
constexpr size_t WS_W1 = 2 * MiB, WS_WO = 6 * MiB, WS_WUP = 8 * MiB, WS_WDN = 16 * MiB;
constexpr size_t WS_WG = 24 * MiB;
constexpr size_t WS_LU = WS_WG + 256 * 1024;
constexpr size_t WS_AGG = 25 * MiB;
constexpr size_t WS_SSQ1 = 27 * MiB, WS_SSQ2 = 29 * MiB;
constexpr size_t WS_X1B = 32 * MiB;
constexpr size_t WS_HN = 66 * MiB;
constexpr size_t WS_XR = 100 * MiB, WS_GG = 117 * MiB, WS_V = 134 * MiB;
constexpr size_t WS_MIX = 151 * MiB;
constexpr size_t WS_U = 66 * MiB;
constexpr size_t WS_END = 198 * MiB;
static_assert(WS_AGG + 265 * 512 * 8 <= WS_SSQ1 && WS_SSQ1 + (size_t)M_MAIN * 64 <= WS_SSQ2 && WS_SSQ2 + (size_t)M_MAIN * 64 <= WS_X1B, "ws map 1");
static_assert(WS_X1B + (size_t)M_MAIN * D * 2 <= WS_HN && WS_HN + (size_t)M_Z * D * 2 <= WS_XR && WS_XR + (size_t)M_Z * 512 * 2 <= WS_GG && WS_GG + (size_t)M_Z * 512 * 2 <= WS_V && WS_V + (size_t)M_Z * 512 * 2 <= WS_MIX, "ws map 2");
static_assert(WS_MIX + (size_t)M_MAIN * D * 2 <= WS_END && WS_U + (size_t)M_MAIN * FF * 2 <= WS_END, "ws map 3");
constexpr int CW_BAR = 4096;
static_assert((CW_BAR + 3456) * 4 <= (int)CTL_ZERO_BYTES, "CTL");
constexpr int RING_BYTES = 131072;
constexpr int MISC_OFF = RING_BYTES;
constexpr int LDS_BYTES = RING_BYTES + 256;

typedef unsigned u32x2v __attribute__((ext_vector_type(2)));
typedef float f32x2v __attribute__((ext_vector_type(2)));
__device__ __forceinline__ float bf_lo(unsigned u) { return __builtin_bit_cast(float, u << 16); }
__device__ __forceinline__ float bf_hi(unsigned u) { return __builtin_bit_cast(float, u & 0xffff0000u); }
__device__ __forceinline__ float sigm(float x) { return __builtin_amdgcn_rcpf(1.0f + __builtin_amdgcn_exp2f(-1.4426950408889634f * x)); }

struct Frame {
    LAS unsigned char* lds;
    int tid, lane, wave, G, bid;
    const float *x_prompt, *x_sample, *st_conv, *st_h, *st_dw, *meta, *norm_mix, *w_in, *cw, *cb, *wgr, *bgr, *wgi, *bgi, *lam, *dww, *dwb, *lng, *lnb, *onr, *onc, *w_out, *norm_mlp, *w_up, *w_down, *norm_final;
    float* out;
    bf16 *W1t, *Wot, *Wupt, *Wdt, *Wg, *HN, *XR, *GG, *V, *MIX, *X1B, *U;
    float *LU, *AGG, *SSQ1, *SSQ2;
};

__device__ __forceinline__ float wave_sum(float v) {
#pragma unroll
    for (int o = 1; o < 64; o <<= 1) v += __shfl_xor(v, o);
    return v;
}
__device__ __forceinline__ void p0_transpose_item(const float* W, int K, int N, bf16* WT, const float* gain, LAS float* scr, int k0, int n0, int dest_row0, int lane) {
#pragma unroll 8
    for (int i = 0; i < 32; ++i) { const int kk = 2 * i + (lane >> 5); float w = W[(size_t)(k0 + kk) * N + n0 + (lane & 31)]; if (gain) w *= gain[k0 + kk]; scr[kk * 33 + (lane & 31)] = w; }
    LDS_WAIT(); asm volatile("" ::: "memory");
    const int c = lane & 7;
#pragma unroll
    for (int j = 0; j < 4; ++j) { const int n = (lane >> 3) + 8 * j; const LAS float* s = scr + (8 * c) * 33 + n;
        v4u o; o.x = pk2(s[0 * 33], s[1 * 33]); o.y = pk2(s[2 * 33], s[3 * 33]); o.z = pk2(s[4 * 33], s[5 * 33]); o.w = pk2(s[6 * 33], s[7 * 33]);
        *(GAS v4u*)(WT + (size_t)(dest_row0 + n) * K + k0 + 8 * c) = o; }
    LDS_WAIT(); asm volatile("" ::: "memory");
}
__device__ __forceinline__ int w1_dest_row(int n0) {
    if (n0 < 1024) return n0;
    if (n0 < 1536) { const int q = (n0 - 1024) >> 7, tc = (n0 - 1024) & 127; return 1024 + 256 * q + tc; }
    { const int q = (n0 - 1536) >> 7, tc = (n0 - 1536) & 127; return 1024 + 256 * q + 128 + tc; }
}
__device__ __forceinline__ void p0_prologue(Frame& F) {
    LAS float* scr = (LAS float*)(F.lds + F.wave * 16384);
    const int gw = F.bid * NWAVES + F.wave, NGW = F.G * NWAVES, lane = F.lane;
    constexpr int I_1 = (D / 64) * (DIN / 32), I_O = (D / 64) * (D / 32), I_U = (D / 64) * (FF / 32), I_D = (FF / 64) * (D / 32);
    constexpr int NITEMS = I_1 + I_O + I_U + I_D;
    for (int it = gw; it < NITEMS; it += NGW) {
        int r = it;
        if (r < I_1) { const int nblk = DIN / 32, kb = r / nblk, nb = r % nblk; p0_transpose_item(F.w_in, D, DIN, F.W1t, nullptr, scr, 64 * kb, 32 * nb, w1_dest_row(32 * nb), lane); continue; } r -= I_1;
        if (r < I_O) { const int nblk = D / 32, kb = r / nblk, nb = r % nblk; p0_transpose_item(F.w_out, D, D, F.Wot, nullptr, scr, 64 * kb, 32 * nb, 32 * nb, lane); continue; } r -= I_O;
        if (r < I_U) { const int nblk = FF / 32, kb = r / nblk, nb = r % nblk; p0_transpose_item(F.w_up, D, FF, F.Wupt, F.norm_mlp, scr, 64 * kb, 32 * nb, 32 * nb, lane); continue; } r -= I_U;
        { const int nblk = D / 32, kb = r / nblk, nb = r % nblk; p0_transpose_item(F.w_down, FF, D, F.Wdt, nullptr, scr, 64 * kb, 32 * nb, 32 * nb, lane); }
    }
    const int gt = F.bid * (NWAVES * 64) + F.tid, NGT = F.G * NWAVES * 64;
    for (int i = gt; i < 2 * NH * HD * HD; i += NGT) { const int g = i >> 15, h = (i >> 12) & 7, e = (i >> 6) & 63, d = i & 63; const float* src = g ? F.wgi : F.wgr; F.Wg[i] = (bf16)f2bf(src[(h * 64 + d) * 64 + e]); }
    for (int i = gt; i < DR; i += NGT) F.LU[i] = -8.0f * log1pf(expf(-F.lam[i]));
    for (int m = gw; m < M_Z; m += NGW) {
        GAS unsigned long long* o8 = (GAS unsigned long long*)(F.HN + (size_t)m * D) + lane;
        if (m >= ROW_META + NMETA) {
#pragma unroll
            for (int j = 0; j < 4; ++j) o8[64 * j] = 0ull;
            continue; }
        const float* xrow = m < M_PROMPT ? F.x_prompt + (size_t)m * D : (m < M_MAIN ? F.x_sample + (size_t)(m - M_PROMPT) * D : F.meta + (size_t)(m - ROW_META) * D);
        const GAS f32x4* xr = (const GAS f32x4*)xrow + lane; const GAS f32x4* gr = (const GAS f32x4*)F.norm_mix + lane;
        f32x4 v[4]; float s = 0.f;
#pragma unroll
        for (int j = 0; j < 4; ++j) { v[j] = xr[64 * j]; s += (v[j].x * v[j].x + v[j].y * v[j].y) + (v[j].z * v[j].z + v[j].w * v[j].w); }
        const float rinv = 1.0f / sqrtf(wave_sum(s) * (1.f / D) + EPS);
#pragma unroll
        for (int j = 0; j < 4; ++j) { const f32x4 g = gr[64 * j]; const f32x4 y = v[j] * rinv * g; o8[64 * j] = (unsigned long long)pk2(y.x, y.y) | ((unsigned long long)pk2(y.z, y.w) << 32); }
    }
}
struct SeqUnit { int kind, b, row0, t0, ntb, j; };
__device__ __forceinline__ SeqUnit seq_unit(int id) {
    SeqUnit u;
    if (id < 256) { u.kind = 0; u.b = id >> 6; u.j = id & 63; u.row0 = u.b * SEQ; u.t0 = 64 * u.j; u.ntb = 4; }
    else if (id < 264) { u.kind = 1; u.b = id - 256; u.j = 0; u.row0 = M_PROMPT + SS * u.b; u.t0 = 0; u.ntb = 4; }
    else { u.kind = 2; u.b = 0; u.j = 0; u.row0 = ROW_META; u.t0 = 0; u.ntb = 1; }
    return u;
}
__device__ __forceinline__ void xr_load4(const Frame& F, const SeqUnit& u, int s, int c, float (&o)[4]) {
    if (s >= 0 || u.kind == 0) {
        const size_t row = s >= 0 ? (size_t)(u.row0 + s) : (size_t)(ROW_META + NMETA + s);
        const u32x2v w = *(const u32x2v*)(F.XR + row * ZCOLS + c); o[0] = bf_lo(w.x); o[1] = bf_hi(w.x); o[2] = bf_lo(w.y); o[3] = bf_hi(w.y);
    } else if (u.kind == 1) { const f32x4 v = *(const f32x4*)(F.st_conv + (size_t)(u.b * 3 + 3 + s) * DR + c); o[0] = v.x; o[1] = v.y; o[2] = v.z; o[3] = v.w; }
    else { o[0] = 0.f; o[1] = 0.f; o[2] = 0.f; o[3] = 0.f; }
}
__device__ __forceinline__ void xr_load8(const Frame& F, const SeqUnit& u, int s, int c, float (&o)[8]) {
    if (s >= 0 || u.kind == 0) {
        const size_t row = s >= 0 ? (size_t)(u.row0 + s) : (size_t)(ROW_META + NMETA + s);
        const v4u w = *(const v4u*)(F.XR + row * ZCOLS + c);
        o[0] = bf_lo(w.x); o[1] = bf_hi(w.x); o[2] = bf_lo(w.y); o[3] = bf_hi(w.y); o[4] = bf_lo(w.z); o[5] = bf_hi(w.z); o[6] = bf_lo(w.w); o[7] = bf_hi(w.w);
    } else if (u.kind == 1) { const float* p = F.st_conv + (size_t)(u.b * 3 + 3 + s) * DR + c; const f32x4 a = *(const f32x4*)p, b = *(const f32x4*)(p + 4);
        o[0] = a.x; o[1] = a.y; o[2] = a.z; o[3] = a.w; o[4] = b.x; o[5] = b.y; o[6] = b.z; o[7] = b.w; }
    else {
#pragma unroll
        for (int j = 0; j < 8; ++j) o[j] = 0.f; }
}
__device__ __forceinline__ float dpp_shr(float v, float ident, int sh) {
    int r;
    switch (sh) {
        case 1: r = __builtin_amdgcn_update_dpp(__builtin_bit_cast(int, ident), __builtin_bit_cast(int, v), 0x111, 0xF, 0xF, false); break;
        case 2: r = __builtin_amdgcn_update_dpp(__builtin_bit_cast(int, ident), __builtin_bit_cast(int, v), 0x112, 0xF, 0xF, false); break;
        case 4: r = __builtin_amdgcn_update_dpp(__builtin_bit_cast(int, ident), __builtin_bit_cast(int, v), 0x114, 0xF, 0xF, false); break;
        default: r = __builtin_amdgcn_update_dpp(__builtin_bit_cast(int, ident), __builtin_bit_cast(int, v), 0x118, 0xF, 0xF, false); break;
    }
    return __builtin_bit_cast(float, r);
}
template <bool PASSB>
__device__ __forceinline__ void rnn_block(const Frame& F, const SeqUnit& u, int tb, float (&H)[4][4], float (&Pc)[4][4]) {
    const int h = F.wave, lane = F.lane; int fr = lane & 15, fq = lane >> 4;
    asm volatile("" : "+v"(fr), "+v"(fq));
    const int s = u.t0 + 16 * tb + fr;
    bf16x8 Xf[2];
#pragma unroll
    for (int ks = 0; ks < 2; ++ks) {
        const int c8 = 64 * h + 32 * ks + 8 * fq; float a8[8];
        { const f32x4 b0 = *(const f32x4*)(F.cb + c8), b1 = *(const f32x4*)(F.cb + c8 + 4); a8[0] = b0.x; a8[1] = b0.y; a8[2] = b0.z; a8[3] = b0.w; a8[4] = b1.x; a8[5] = b1.y; a8[6] = b1.z; a8[7] = b1.w; }
#pragma unroll
        for (int k = 0; k < 4; ++k) { float x8[8]; xr_load8(F, u, s - 3 + k, c8, x8); const f32x4 w0 = *(const f32x4*)(F.cw + k * DR + c8), w1 = *(const f32x4*)(F.cw + k * DR + c8 + 4);
            a8[0] += w0.x * x8[0]; a8[1] += w0.y * x8[1]; a8[2] += w0.z * x8[2]; a8[3] += w0.w * x8[3]; a8[4] += w1.x * x8[4]; a8[5] += w1.y * x8[5]; a8[6] += w1.z * x8[6]; a8[7] += w1.w * x8[7]; }
        v4u pk; pk.x = pk2(a8[0], a8[1]); pk.y = pk2(a8[2], a8[3]); pk.z = pk2(a8[4], a8[5]); pk.w = pk2(a8[6], a8[7]);
        Xf[ks] = __builtin_bit_cast(bf16x8, pk);
        asm volatile("" ::: "memory");
    }
    float ssq = 0.f;
    bf16* orow = F.MIX + (size_t)(u.row0 + s) * D;
#pragma unroll
    for (int eb = 0; eb < 4; ++eb) {
        asm volatile("" ::: "memory");
        const bf16* wp = F.Wg + ((size_t)h * HD + 16 * eb + fr) * HD + 8 * fq;
        const bf16x8 Wr0 = *(const bf16x8*)wp, Wr1 = *(const bf16x8*)(wp + 32), Wi0 = *(const bf16x8*)(wp + NH * HD * HD), Wi1 = *(const bf16x8*)(wp + NH * HD * HD + 32);
        f32x4 ar = {0.f, 0.f, 0.f, 0.f}, ai = {0.f, 0.f, 0.f, 0.f};
        ar = __builtin_amdgcn_mfma_f32_16x16x32_bf16(Wr0, Xf[0], ar, 0, 0, 0); ar = __builtin_amdgcn_mfma_f32_16x16x32_bf16(Wr1, Xf[1], ar, 0, 0, 0);
        ai = __builtin_amdgcn_mfma_f32_16x16x32_bf16(Wi0, Xf[0], ai, 0, 0, 0); ai = __builtin_amdgcn_mfma_f32_16x16x32_bf16(Wi1, Xf[1], ai, 0, 0, 0);
        const int c4 = 64 * h + 16 * eb + 4 * fq;
        float xc[4]; { const f32x4 b0 = *(const f32x4*)(F.cb + c4); xc[0] = b0.x; xc[1] = b0.y; xc[2] = b0.z; xc[3] = b0.w; }
#pragma unroll
        for (int k = 0; k < 4; ++k) { float x4[4]; xr_load4(F, u, s - 3 + k, c4, x4); const f32x4 w0 = *(const f32x4*)(F.cw + k * DR + c4);
            xc[0] += w0.x * x4[0]; xc[1] += w0.y * x4[1]; xc[2] += w0.z * x4[2]; xc[3] += w0.w * x4[3]; }
        const f32x4 br = *(const f32x4*)(F.bgr + c4), bi = *(const f32x4*)(F.bgi + c4), lu = *(const f32x4*)(F.LU + c4);
        float gg[4] = {0.f, 0.f, 0.f, 0.f}; f32x4 og = {0.f, 0.f, 0.f, 0.f};
        if (PASSB) { const u32x2v w = *(const u32x2v*)(F.GG + (size_t)(u.row0 + s) * ZCOLS + c4); gg[0] = bf_lo(w.x); gg[1] = bf_hi(w.x); gg[2] = bf_lo(w.y); gg[3] = bf_hi(w.y); og = *(const f32x4*)(F.onr + c4); }
        float y[4];
#pragma unroll
        for (int r = 0; r < 4; ++r) {
            const float rg = sigm(ar[r] + br[r]), ig = sigm(ai[r] + bi[r]);
            float A = __builtin_amdgcn_exp2f(1.4426950408889634f * rg * lu[r]);
            float B = sqrtf(fmaxf(1.0f - A * A, 0.f)) * ig * xc[r];
#pragma unroll
            for (int sh = 1; sh < 16; sh <<= 1) { const float Ap = dpp_shr(A, 1.0f, sh), Bp = dpp_shr(B, 0.0f, sh); B = A * Bp + B; A = A * Ap; }
            const float hl = A * H[eb][r] + B;
            H[eb][r] = __shfl(hl, (lane & 48) | 15);
            if (!PASSB) Pc[eb][r] *= __shfl(A, (lane & 48) | 15);
            if (PASSB) { y[r] = hl * gg[r]; ssq += y[r] * y[r]; }
        }
        if (PASSB) { u32x2v w; w.x = pk2(y[0] * og[0], y[1] * og[1]); w.y = pk2(y[2] * og[2], y[3] * og[3]); *(u32x2v*)(orow + c4) = w; }
    }
    if (PASSB) { LAS float* red = (LAS float*)F.lds; ssq += __shfl_xor(ssq, 16); ssq += __shfl_xor(ssq, 32); if (fq == 0) red[(16 * tb + fr) * 8 + h] = ssq; }
}
template <bool PASSB>
__device__ __forceinline__ void rnn_unit(Frame& F, int uid) {
    const SeqUnit u = seq_unit(uid);
    const int h = F.wave, lane = F.lane, fr = lane & 15, fq = lane >> 4;
    float H[4][4], Pc[4][4];
#pragma unroll
    for (int eb = 0; eb < 4; ++eb)
#pragma unroll
        for (int r = 0; r < 4; ++r) { H[eb][r] = 0.f; Pc[eb][r] = 1.f; }
    if (PASSB) {
        if (u.kind == 1) {
#pragma unroll
            for (int eb = 0; eb < 4; ++eb) { const f32x4 v = *(const f32x4*)(F.st_h + (size_t)u.b * DR + 64 * h + 16 * eb + 4 * fq); H[eb][0] = v.x; H[eb][1] = v.y; H[eb][2] = v.z; H[eb][3] = v.w; }
        } else {
#pragma unroll
            for (int eb = 0; eb < 4; ++eb) { const float* p = F.AGG + ((size_t)264 * DR + 64 * h + 16 * eb + 4 * fq) * 2; const f32x4 a = *(const f32x4*)p, b = *(const f32x4*)(p + 4); H[eb][0] = a.y; H[eb][1] = a.w; H[eb][2] = b.y; H[eb][3] = b.w; }
#pragma unroll 1
            for (int jj = 0; jj < u.j; ++jj) {
#pragma unroll
                for (int eb = 0; eb < 4; ++eb) { const float* p = F.AGG + ((size_t)(u.b * 64 + jj) * DR + 64 * h + 16 * eb + 4 * fq) * 2; const f32x4 a = *(const f32x4*)p, b = *(const f32x4*)(p + 4);
                    H[eb][0] = a.x * H[eb][0] + a.y; H[eb][1] = a.z * H[eb][1] + a.w; H[eb][2] = b.x * H[eb][2] + b.y; H[eb][3] = b.z * H[eb][3] + b.w; }
            }
        }
    }
#pragma unroll 1
    for (int tb = 0; tb < u.ntb; ++tb) rnn_block<PASSB>(F, u, tb, H, Pc);
    if (!PASSB) {
        if (fr == 0) {
#pragma unroll
            for (int eb = 0; eb < 4; ++eb) { float* p = F.AGG + ((size_t)uid * DR + 64 * h + 16 * eb + 4 * fq) * 2;
                *(f32x4*)p = (f32x4){Pc[eb][0], H[eb][0], Pc[eb][1], H[eb][1]}; *(f32x4*)(p + 4) = (f32x4){Pc[eb][2], H[eb][2], Pc[eb][3], H[eb][3]}; }
        }
    } else {
        LAS float* red = (LAS float*)F.lds;
        __syncthreads();
#pragma unroll 1
        for (int tb = 0; tb < 4; ++tb) {
            const LAS f32x4* rp = (const LAS f32x4*)(red + (16 * tb + fr) * 8); const f32x4 a = rp[0], b = rp[1];
            const float rinv = 1.0f / sqrtf(((a.x + a.y) + (a.z + a.w) + (b.x + b.y) + (b.z + b.w)) * (1.0f / DR) + EPS);
            bf16* orow = F.MIX + (size_t)(u.row0 + u.t0 + 16 * tb + fr) * D + 64 * h + 4 * fq;
#pragma unroll
            for (int eb = 0; eb < 4; ++eb) { u32x2v w = *(u32x2v*)(orow + 16 * eb);
                w.x = pk2(bf_lo(w.x) * rinv, bf_hi(w.x) * rinv); w.y = pk2(bf_lo(w.y) * rinv, bf_hi(w.y) * rinv); *(u32x2v*)(orow + 16 * eb) = w; }
        }
        if (fr == 0 && (u.kind == 1 || u.j == 63)) {
            float* ho = F.out + (u.kind == 1 ? O_H_S : O_H_P) + (size_t)u.b * DR;
#pragma unroll
            for (int eb = 0; eb < 4; ++eb) *(f32x4*)(ho + 64 * h + 16 * eb + 4 * fq) = (f32x4){H[eb][0], H[eb][1], H[eb][2], H[eb][3]};
        }
        __syncthreads();
    }
}
template <int N> __device__ __forceinline__ float xreduce(float (&v)[N], int lane) {
#pragma unroll
    for (int half = N / 2, off = 32; half >= 1; half >>= 1, off >>= 1) {
        const bool up = (lane & off) != 0;
#pragma unroll
        for (int i = 0; i < half; ++i) { const float send = up ? v[i] : v[i + half], keep = up ? v[i + half] : v[i]; v[i] = keep + __shfl_xor(send, off); }
    }
    float r = v[0];
#pragma unroll
    for (int off = 32 / N; off >= 1; off >>= 1) r += __shfl_xor(r, off);
    return r;
}
__device__ __forceinline__ void conv_unit(Frame& F, int uid) {
    const SeqUnit u = seq_unit(uid);
    const int lane = F.lane, tg = F.wave >> 2, cg = F.wave & 3, c0_ = 128 * cg + 2 * lane;
    LAS float* red1 = (LAS float*)(F.lds);
    LAS float* red2 = (LAS float*)(F.lds + 512);
    LAS unsigned char* vt = F.lds + 8192;
#pragma unroll 1
    for (int r = F.wave; r < 94; r += NWAVES) {
        const int s = u.t0 - 30 + r; v4u val = {0u, 0u, 0u, 0u};
        if (s >= 0) val = *(const v4u*)(F.V + (size_t)(u.row0 + s) * ZCOLS + 8 * lane);
        else if (u.kind == 0) { if (NMETA + s >= 0) val = *(const v4u*)(F.V + (size_t)(ROW_META + NMETA + s) * ZCOLS + 8 * lane); }
        else { const float* p = F.st_dw + (size_t)(u.b * 30 + 30 + s) * DC + 8 * lane; const f32x4 a = *(const f32x4*)p, b = *(const f32x4*)(p + 4);
            val.x = pk2(a.x, a.y); val.y = pk2(a.z, a.w); val.z = pk2(b.x, b.y); val.w = pk2(b.z, b.w); }
        *(LAS v4u*)(vt + r * 1024 + 16 * lane) = val;
    }
    f32x2v w[31];
    unsigned cb4 = (unsigned)c0_ * 4u; asm volatile("" : "+v"(cb4));
#pragma unroll
    for (int k = 0; k < 31; ++k) w[k] = *(const f32x2v*)((const char*)(F.dww + k * DC) + cb4);
    const f32x2v bias = *(const f32x2v*)((const char*)F.dwb + cb4), lg = *(const f32x2v*)((const char*)F.lng + cb4), lb = *(const f32x2v*)((const char*)F.lnb + cb4), og = *(const f32x2v*)((const char*)F.onc + cb4);
    __syncthreads();
#pragma unroll 1
    for (int bb = 0; bb < 4; ++bb) {
        const int rb = 32 * tg + 8 * bb;
        const int tb0 = u.t0 + rb;
        int c0 = c0_; asm volatile("" : "+v"(c0));
        f32x2v vc[8]; float st[16];
#pragma unroll
        for (int j = 0; j < 8; ++j) vc[j] = bias;
        const LAS unsigned char* vp = vt + rb * 1024 + 2 * c0;
#pragma unroll
        for (int i = 0; i < 38; ++i) { const unsigned xw = *(const LAS unsigned*)(vp + i * 1024); const f32x2v x = {bf_lo(xw), bf_hi(xw)};
#pragma unroll
            for (int j = 0; j < 8; ++j) { const int k = i - j; if (k >= 0 && k < 31) vc[j] += w[k] * x; }
            if ((i & 7) == 7) asm volatile("" ::: "memory"); }
#pragma unroll
        for (int j = 0; j < 8; ++j) { const f32x2v a = vc[j]; st[j] = a.x + a.y; st[8 + j] = a.x * a.x + a.y * a.y; }
        { const float tot = xreduce<16>(st, lane); if ((lane & 3) == 0) red1[(tg * 16 + ((lane >> 2) & 15)) * 4 + cg] = tot; }
        __syncthreads();
        float q[8];
#pragma unroll
        for (int j = 0; j < 8; ++j) {
            const f32x4 a = *(const LAS f32x4*)(red1 + (tg * 16 + j) * 4), b = *(const LAS f32x4*)(red1 + (tg * 16 + 8 + j) * 4);
            const float mean = ((a.x + a.y) + (a.z + a.w)) * (1.0f / DC), ex2 = ((b.x + b.y) + (b.z + b.w)) * (1.0f / DC);
            const float rstd = 1.0f / sqrtf(fmaxf(ex2 - mean * mean, 0.f) + EPS);
            f32x2v y = (vc[j] - mean) * rstd * lg + lb; y.x *= sigm(y.x); y.y *= sigm(y.y);
            vc[j] = y; q[j] = y.x * y.x + y.y * y.y; }
        { const float tot = xreduce<8>(q, lane); if ((lane & 7) == 0) red2[(tg * 8 + ((lane >> 3) & 7)) * 4 + cg] = tot; }
        __syncthreads();
#pragma unroll
        for (int j = 0; j < 8; ++j) {
            const f32x4 a = *(const LAS f32x4*)(red2 + (tg * 8 + j) * 4);
            const float rinv = 1.0f / sqrtf(((a.x + a.y) + (a.z + a.w)) * (1.0f / DC) + EPS);
            const f32x2v y = vc[j] * rinv * og;
            *(unsigned*)(F.MIX + (size_t)(u.row0 + tb0 + j) * D + DR + c0) = pk2(y.x, y.y); }
    }
}
__device__ __forceinline__ void state_copy(Frame& F) {
    const int gt = F.bid * (NWAVES * 64) + F.tid, NGT = F.G * NWAVES * 64;
    constexpr int NC = (NB + SB) * 3 * DR, NDW = (NB + SB) * 30 * DC;
    for (int i = gt; i < NC + NDW; i += NGT) {
        if (i < NC) { const int c = i & 511, j = (i >> 9) % 3, sq = (i >> 9) / 3;
            if (sq < NB) F.out[O_CONV_P + (size_t)(sq * 3 + j) * DR + c] = bf_lo(F.XR[(size_t)(sq * SEQ + SEQ - 3 + j) * ZCOLS + c]);
            else { const int b = sq - NB; F.out[O_CONV_S + (size_t)(b * 3 + j) * DR + c] = bf_lo(F.XR[(size_t)(M_PROMPT + b * SS + SS - 3 + j) * ZCOLS + c]); }
        } else { const int i2 = i - NC, c = i2 & 511, j = (i2 >> 9) % 30, sq = (i2 >> 9) / 30;
            if (sq < NB) F.out[O_DW_P + (size_t)(sq * 30 + j) * DC + c] = bf_lo(F.V[(size_t)(sq * SEQ + SEQ - 30 + j) * ZCOLS + c]);
            else { const int b = sq - NB; F.out[O_DW_S + (size_t)(b * 30 + j) * DC + c] = bf_lo(F.V[(size_t)(M_PROMPT + b * SS + SS - 30 + j) * ZCOLS + c]); }
        }
    }
}
__device__ __forceinline__ void final_norm(Frame& F) {
    const int gw = F.bid * NWAVES + F.wave, NGW = F.G * NWAVES, lane = F.lane;
    for (int m = gw; m < M_MAIN; m += NGW) {
        const float p = lane < 16 ? F.SSQ2[(size_t)m * 16 + lane] : 0.f;
        const float rinv = 1.0f / sqrtf(wave_sum(p) * (1.0f / D) + EPS);
        GAS f32x4* xr = (GAS f32x4*)(F.out + (size_t)m * D) + lane; const GAS f32x4* gr = (const GAS f32x4*)F.norm_final + lane;
        f32x4 v[4];
#pragma unroll
        for (int j = 0; j < 4; ++j) v[j] = xr[64 * j];
#pragma unroll
        for (int j = 0; j < 4; ++j) xr[64 * j] = v[j] * rinv * gr[64 * j];
    }
}
struct Args { const float* in[26]; float* out; unsigned char* ws; int ph_lo, ph_hi; };
__global__ void __launch_bounds__(NWAVES * 64, 2) hymba_fwd(Args args) {
    __shared__ __attribute__((aligned(16))) unsigned char lds_raw[LDS_BYTES];
    Frame F;
    F.lds = (LAS unsigned char*)lds_raw;
    F.tid = threadIdx.x; F.lane = F.tid & 63; F.wave = __builtin_amdgcn_readfirstlane(F.tid >> 6); F.G = gridDim.x; F.bid = blockIdx.x;
    unsigned char* ws = args.ws;
    F.x_prompt = args.in[0]; F.x_sample = args.in[1]; F.st_conv = args.in[2]; F.st_h = args.in[3]; F.st_dw = args.in[4]; F.meta = args.in[5]; F.norm_mix = args.in[6]; F.w_in = args.in[7];
    F.cw = args.in[8]; F.cb = args.in[9]; F.wgr = args.in[10]; F.bgr = args.in[11]; F.wgi = args.in[12]; F.bgi = args.in[13]; F.lam = args.in[14]; F.dww = args.in[15]; F.dwb = args.in[16];
    F.lng = args.in[17]; F.lnb = args.in[18]; F.onr = args.in[19]; F.onc = args.in[20]; F.w_out = args.in[21]; F.norm_mlp = args.in[22]; F.w_up = args.in[23]; F.w_down = args.in[24]; F.norm_final = args.in[25];
    F.out = args.out;
    F.W1t = (bf16*)(ws + WS_W1); F.Wot = (bf16*)(ws + WS_WO); F.Wupt = (bf16*)(ws + WS_WUP); F.Wdt = (bf16*)(ws + WS_WDN); F.Wg = (bf16*)(ws + WS_WG); F.LU = (float*)(ws + WS_LU);
    F.AGG = (float*)(ws + WS_AGG); F.SSQ1 = (float*)(ws + WS_SSQ1); F.SSQ2 = (float*)(ws + WS_SSQ2); F.X1B = (bf16*)(ws + WS_X1B);
    F.HN = (bf16*)(ws + WS_HN); F.XR = (bf16*)(ws + WS_XR); F.GG = (bf16*)(ws + WS_GG); F.V = (bf16*)(ws + WS_V); F.MIX = (bf16*)(ws + WS_MIX); F.U = (bf16*)(ws + WS_U);
    volatile LAS unsigned* MISC = (volatile LAS unsigned*)(F.lds + MISC_OFF);
    if (F.tid < 64) MISC[F.tid] = 0u;
    __syncthreads();
    XcdBarrier bar = xcd_barrier_post((unsigned*)(ws + WS_CTL) + CW_BAR, MISC + 8);
    const int lo = args.ph_lo, hi = args.ph_hi;
#ifndef PHMASK
#define PHMASK 0xFF
#endif
#define IN(k) (((PHMASK >> (k)) & 1) && lo <= (k) && (k) < hi)
#define SEAM(k) do { if (IN(k) && IN((k) + 1)) xcd_barrier(bar); } while (0)
    if (IN(0)) { p0_prologue(F); } SEAM(0);
    if (IN(1)) { pg8::Gemm g{F.HN, F.W1t, M_Z, DIN, D}; pg8::StaticOrder S; S.init(M_Z, DIN, F.G, F.bid); pg8::EpiZ E{F.XR, F.GG, F.V};
        pg8::gemm_phase<pg8::EpiZ, pg8::StaticOrder, true, true>(F.lds, g, S, E); } SEAM(1);
    if (IN(2)) {
#ifndef NO_CONV
        for (int uu = F.bid; uu < 264; uu += F.G) conv_unit(F, uu);
#endif
#ifndef NO_RNNA
        for (int uu = F.G - 1 - F.bid; uu < 265; uu += F.G) rnn_unit<false>(F, uu);
#endif
        state_copy(F); } SEAM(2);
    if (IN(3)) { for (int uu = F.bid; uu < 264; uu += F.G) rnn_unit<true>(F, uu); } SEAM(3);
    if (IN(4)) { pg8::Gemm g{F.MIX, F.Wot, M_MAIN, D, D}; pg8::StaticOrder S; S.init(M_MAIN, D, F.G, F.bid); pg8::EpiRes<true> E{F.x_prompt, F.x_sample, M_PROMPT / 256, F.out, F.X1B, F.SSQ1};
        pg8::gemm_phase<pg8::EpiRes<true>, pg8::StaticOrder, true, true>(F.lds, g, S, E); } SEAM(4);
    if (IN(5)) { pg8::Gemm g{F.X1B, F.Wupt, M_MAIN, FF, D}; pg8::StaticOrder S; S.init(M_MAIN, FF, F.G, F.bid); pg8::EpiU E{F.SSQ1, F.U, FF};
        pg8::gemm_phase<pg8::EpiU, pg8::StaticOrder, true, true>(F.lds, g, S, E); } SEAM(5);
    if (IN(6)) { pg8::Gemm g{F.U, F.Wdt, M_MAIN, D, FF}; pg8::StaticOrder S; S.init(M_MAIN, D, F.G, F.bid); pg8::EpiRes<false> E{F.out, F.out, 1 << 20, F.out, nullptr, F.SSQ2};
        pg8::gemm_phase<pg8::EpiRes<false>, pg8::StaticOrder, true, true>(F.lds, g, S, E); } SEAM(6);
    if (IN(7)) final_norm(F);
#undef IN
#undef SEAM
}
extern "C" void kernel_launch(void* const* d_in, const int* in_sizes, int n_in, void* d_out, int out_size, void* d_ws, size_t ws_size, hipStream_t stream) {
    static int grid = 0;
    if (grid == 0) {
        if (n_in != 26 || out_size != (int)O_END || ws_size < WS_END) { fprintf(stderr, "kernel_launch: unexpected shapes (n_in %d, out %d, ws %zu)\n", n_in, out_size, ws_size); grid = -1; return; }
        int dev = 0, cus = 0, per_cu = 0;
        if (hipGetDevice(&dev) != hipSuccess || hipDeviceGetAttribute(&cus, hipDeviceAttributeMultiprocessorCount, dev) != hipSuccess) { grid = -1; return; }
        if (hipOccupancyMaxActiveBlocksPerMultiprocessor(&per_cu, (const void*)hymba_fwd, NWAVES * 64, 0) != hipSuccess || per_cu < 1) { fprintf(stderr, "kernel_launch: occupancy query says %d blocks per CU\n", per_cu); (void)hipGetLastError(); grid = -1; return; }
        grid = cus;
    }
    if (grid < 0) return;
    if (hipMemsetAsync((char*)d_ws + WS_CTL, 0, CTL_ZERO_BYTES, stream) != hipSuccess) return;
    Args a{};
    for (int i = 0; i < 26; ++i) a.in[i] = (const float*)d_in[i];
    a.out = (float*)d_out; a.ws = (unsigned char*)d_ws; a.ph_lo = 0; a.ph_hi = 8;
    hipLaunchKernelGGL(hymba_fwd, dim3(grid), dim3(NWAVES * 64), 0, stream, a);
}
```

```cpp
#include <hip/hip_runtime.h>
#include <cstdio>
#include <cstdint>
#include <cmath>
namespace pg8 {
#define PG8_LAS __attribute__((address_space(3)))
typedef unsigned short bf16_t;
typedef short bf16x8 __attribute__((ext_vector_type(8)));
typedef float f32x4 __attribute__((ext_vector_type(4)));
typedef unsigned u32x4 __attribute__((ext_vector_type(4)));
constexpr int BM = 256, BK = 64, HALF = 128, HTB = HALF * BK * 2  , STAGE_BYTES = 8 * HTB, NXCD = 8, WGM = 8;

__host__ __device__ __forceinline__ int lds_byte(int r, int c) { const int st = (r >> 4) * 2 + (c >> 5), rr = r & 15, cc = c & 31, ob = rr * 64 + cc * 2; return st * 1024 + (ob ^ (((ob >> 9) & 1) << 5)); }
__host__ __device__ __forceinline__ void stage_rc(int b, int& R, int& C) { const int st = b / 1024, sb = b % 1024, swz = sb ^ (((sb >> 9) & 1) << 5); R = (st >> 1) * 16 + swz / 64; C = (st & 1) * 32 + (swz % 64) / 2; }
__host__ __device__ __forceinline__ int perm32(int rho) { const int n = rho >> 4, i = rho & 15; return 8 * (i >> 2) + 4 * n + (i & 3); }

struct Unit { int pm, pn; };
struct Gemm { const bf16_t* A; const bf16_t* Bt; int M, N, K; };

struct StaticOrder {
    int nM, nN, nwg, G, c;
    __host__ __device__ void init(int M, int N, int G_, int c_) { nM = M / BM; nN = N / BM; nwg = nM * nN; G = G_; c = c_; }
    __host__ __device__ bool next(int i, Unit& u) const {
        const long L = (long)i * G + c; if (L >= nwg) return false;
        int wgid = (int)L; { const int q = nwg / NXCD, r = nwg % NXCD, xcd = wgid % NXCD, off = wgid / NXCD; wgid = (xcd < r ? xcd * (q + 1) : r * (q + 1) + (xcd - r) * q) + off; }
        const int nig = WGM * nN, gid = wgid / nig, fm = gid * WGM, gsz = (nM - fm) < WGM ? (nM - fm) : WGM;
        u.pm = fm + ((wgid % nig) % gsz); u.pn = (wgid % nig) / gsz; return true;
    }
    __device__ __forceinline__ void a_ready(const Unit&) const {}
    __device__ __forceinline__ void done(const Unit&) const {}
};

__device__ __forceinline__ unsigned cvt_pk_bf16(float lo, float hi) { unsigned r; asm volatile("v_cvt_pk_bf16_f32 %0, %1, %2" : "=v"(r) : "v"(lo), "v"(hi)); return r; }
typedef float f32x2 __attribute__((ext_vector_type(2)));
__device__ __forceinline__ float fast_sigmoid(float x) { return __builtin_amdgcn_rcpf(1.0f + __builtin_amdgcn_exp2f(-1.4426950408889634f * x)); }
__device__ __forceinline__ float gelu_tanh(float x) {
    const float t = x * (1.0f + 0.044715f * x * x);
    return x * __builtin_amdgcn_rcpf(1.0f + __builtin_amdgcn_exp2f(-2.3022081985f * t));
}
constexpr int ZC = 512;
struct EpiZ {
    static constexpr bool PERM = true, AFTER_DRAIN = false;
    bf16_t *XR, *GG, *V;
    __device__ __forceinline__ void operator()(const f32x4 (&acc)[2][2][4][2], const Unit& u, int wr, int wc, int fr, int fq) const {
        const int row0 = u.pm * BM + wr * 64 + fr, cw = wc * 32 + 8 * fq;
        if (u.pn < 4) {
            bf16_t* base = (u.pn < 2 ? XR : GG) + (u.pn & 1) * 256 + cw; const bool act = u.pn >= 2;
#pragma unroll
            for (int ai = 0; ai < 2; ++ai)
#pragma unroll
                for (int m = 0; m < 4; ++m) { bf16_t* rowp = base + (size_t)(row0 + ai * HALF + m * 16) * ZC;
#pragma unroll
                    for (int bj = 0; bj < 2; ++bj) { f32x4 v0 = acc[ai][bj][m][0], v1 = acc[ai][bj][m][1];
                        if (act) {
#pragma unroll
                            for (int j = 0; j < 4; ++j) { v0[j] = gelu_tanh(v0[j]); v1[j] = gelu_tanh(v1[j]); } }
                        u32x4 w; w.x = cvt_pk_bf16(v0[0], v0[1]); w.y = cvt_pk_bf16(v0[2], v0[3]); w.z = cvt_pk_bf16(v1[0], v1[1]); w.w = cvt_pk_bf16(v1[2], v1[3]);
                        *(u32x4*)(rowp + bj * HALF) = w; } }
        } else {
            bf16_t* base = V + (u.pn - 4) * 128 + cw;
#pragma unroll
            for (int ai = 0; ai < 2; ++ai)
#pragma unroll
                for (int m = 0; m < 4; ++m) { bf16_t* rowp = base + (size_t)(row0 + ai * HALF + m * 16) * ZC;
                    f32x4 v0 = acc[ai][0][m][0], v1 = acc[ai][0][m][1]; const f32x4 g0 = acc[ai][1][m][0], g1 = acc[ai][1][m][1];
#pragma unroll
                    for (int j = 0; j < 4; ++j) { v0[j] *= fast_sigmoid(g0[j]); v1[j] *= fast_sigmoid(g1[j]); }
                    u32x4 w; w.x = cvt_pk_bf16(v0[0], v0[1]); w.y = cvt_pk_bf16(v0[2], v0[3]); w.z = cvt_pk_bf16(v1[0], v1[1]); w.w = cvt_pk_bf16(v1[2], v1[3]);
                    *(u32x4*)rowp = w; }
        }
    }
};
typedef unsigned u32x2 __attribute__((ext_vector_type(2)));
template <bool WITH_BF16> struct EpiRes {
    static constexpr bool PERM = false, AFTER_DRAIN = false;
    const float* xa; const float* xb; int pm_split;
    float* X1; bf16_t* X1B; float* SSQ;
    __device__ __forceinline__ void operator()(const f32x4 (&acc)[2][2][4][2], const Unit& u, int wr, int wc, int fr, int fq) const {
        const float* xin = (u.pm < pm_split) ? xa + (size_t)u.pm * BM * 1024 : xb + (size_t)(u.pm - pm_split) * BM * 1024;
        const int col0 = u.pn * BM + wc * 32 + 4 * fq;
#pragma unroll
        for (int ai = 0; ai < 2; ++ai)
#pragma unroll
            for (int m = 0; m < 4; ++m) { const int rl = ai * HALF + wr * 64 + m * 16 + fr; const size_t R = (size_t)u.pm * BM + rl; float s = 0.f;
#pragma unroll
                for (int bj = 0; bj < 2; ++bj)
#pragma unroll
                    for (int n = 0; n < 2; ++n) { const int off = col0 + bj * HALF + n * 16; const f32x4 xv = *(const f32x4*)(xin + (size_t)rl * 1024 + off); const f32x4 o = xv + acc[ai][bj][m][n];
                        *(f32x4*)(X1 + R * 1024 + off) = o; s += (o[0] * o[0] + o[1] * o[1]) + (o[2] * o[2] + o[3] * o[3]);
                        if (WITH_BF16) { u32x2 w; w.x = cvt_pk_bf16(o[0], o[1]); w.y = cvt_pk_bf16(o[2], o[3]); *(u32x2*)(X1B + R * 1024 + off) = w; } }
                s += __shfl_xor(s, 16); s += __shfl_xor(s, 32);
                if (fq == 0) SSQ[R * 16 + u.pn * 4 + wc] = s;
                asm volatile("" ::: "memory"); }
    }
};
struct EpiU {
    static constexpr bool PERM = true, AFTER_DRAIN = false;
    const float* SSQ; bf16_t* U; int ldc;
    __device__ __forceinline__ void operator()(const f32x4 (&acc)[2][2][4][2], const Unit& u, int wr, int wc, int fr, int fq) const {
        const int row0 = u.pm * BM + wr * 64 + fr, col0 = u.pn * BM + wc * 32 + 8 * fq;
#pragma unroll
        for (int ai = 0; ai < 2; ++ai)
#pragma unroll
            for (int m = 0; m < 4; ++m) { const size_t R = (size_t)(row0 + ai * HALF + m * 16);
                const f32x4 p0 = *(const f32x4*)(SSQ + R * 16), p1 = *(const f32x4*)(SSQ + R * 16 + 4), p2 = *(const f32x4*)(SSQ + R * 16 + 8), p3 = *(const f32x4*)(SSQ + R * 16 + 12);
                const f32x4 ps = (p0 + p1) + (p2 + p3); const float rinv = __builtin_amdgcn_rsqf(((ps[0] + ps[1]) + (ps[2] + ps[3])) * (1.0f / 1024.0f) + 1e-6f);
                bf16_t* rowp = U + R * ldc + col0;
#pragma unroll
                for (int bj = 0; bj < 2; ++bj) { f32x4 v0 = acc[ai][bj][m][0] * rinv, v1 = acc[ai][bj][m][1] * rinv;
#pragma unroll
                    for (int j = 0; j < 4; ++j) { const float a = fmaxf(v0[j], 0.f), b = fmaxf(v1[j], 0.f); v0[j] = a * a; v1[j] = b * b; }
                    u32x4 w; w.x = cvt_pk_bf16(v0[0], v0[1]); w.y = cvt_pk_bf16(v0[2], v0[3]); w.z = cvt_pk_bf16(v1[0], v1[1]); w.w = cvt_pk_bf16(v1[2], v1[3]);
                    *(u32x4*)(rowp + bj * HALF) = w; } }
    }
};
template <class Epi, class Sched, bool ALIGN_EPI = false, bool SP2 = false>
__device__ __forceinline__ void gemm_phase(PG8_LAS unsigned char* lds, const Gemm g, const Sched& S, const Epi& E) {
    const int tid = threadIdx.x, wid = __builtin_amdgcn_readfirstlane(tid >> 6), lane = tid & 63, wr = wid >> 2, wc = wid & 3, fr = lane & 15, fq = lane >> 4;
    const int K = g.K, nt = K / BK;
    unsigned voffA[2], voffB[2];
#pragma unroll
    for (int i = 0; i < 2; ++i) { int R, C; stage_rc(tid * 16 + i * 8192, R, C); const int Rb = Epi::PERM ? ((R & ~31) + perm32(R & 31)) : R;
        voffA[i] = (unsigned)(R * K + C) * 2u; voffB[i] = (unsigned)(Rb * K + C) * 2u; }
    const size_t kstep = (size_t)(BK * 2);
    const size_t hstep = (size_t)HALF * K * 2;
    const size_t tstep = 2 * hstep;
    const unsigned ldsw = (unsigned)wid * 1024u;
    const int aoff = lds_byte(wr * 64 + fr, fq * 8), boff = lds_byte(wc * 32 + fr, fq * 8);
#define PG8_SA(b, h) (((b) * 2 + (h)) * HTB)
#define PG8_SB(b, h) ((4 + (b) * 2 + (h)) * HTB)
#define PG8_STAGE(bufoff, gbase, voff) do { _Pragma("unroll") for (int _i = 0; _i < 2; ++_i) \
        __builtin_amdgcn_global_load_lds((const unsigned*)((const char*)(gbase) + (voff)[_i]), (PG8_LAS unsigned*)(lds + (bufoff) + ldsw + _i * 8192), 16, 0, 0); } while (0)
#define PG8_LDA(dst, b, h) do { _Pragma("unroll") for (int m = 0; m < 4; ++m) _Pragma("unroll") for (int k = 0; k < 2; ++k) dst[m][k] = *(const PG8_LAS bf16x8*)(lds + PG8_SA(b, h) + aoff + m * 2048 + k * 1024); } while (0)
#define PG8_LDB(dst, b, h) do { _Pragma("unroll") for (int n = 0; n < 2; ++n) _Pragma("unroll") for (int k = 0; k < 2; ++k) dst[n][k] = *(const PG8_LAS bf16x8*)(lds + PG8_SB(b, h) + boff + n * 2048 + k * 1024); } while (0)
#define PG8_MMA(ai, bj, At, Bt) do { __builtin_amdgcn_s_setprio(1); _Pragma("unroll") for (int m = 0; m < 4; ++m) _Pragma("unroll") for (int n = 0; n < 2; ++n) _Pragma("unroll") for (int k = 0; k < 2; ++k) \
        acc[ai][bj][m][n] = __builtin_amdgcn_mfma_f32_16x16x32_bf16(Bt[n][k], At[m][k], acc[ai][bj][m][n], 0, 0, 0); __builtin_amdgcn_s_setprio(0); } while (0)
#define PG8_WAIT_V(n) asm volatile("s_waitcnt vmcnt(" #n ")" ::: "memory")
#define PG8_WAIT_L(n) asm volatile("s_waitcnt lgkmcnt(" #n ")" ::: "memory")
#define PG8_BAR __builtin_amdgcn_s_barrier()
#define PG8_SCHED __builtin_amdgcn_sched_barrier(0)
    Unit cur, nxt; int ui = 0;
    if (!S.next(0, cur)) return;
    f32x4 acc[2][2][4][2];
#pragma unroll
    for (int a = 0; a < 2; ++a)
#pragma unroll
        for (int b = 0; b < 2; ++b)
#pragma unroll
            for (int m = 0; m < 4; ++m)
#pragma unroll
                for (int n = 0; n < 2; ++n) acc[a][b][m][n] = (f32x4){0.f, 0.f, 0.f, 0.f};
    bf16x8 At[4][2], B0[2][2], B1[2][2];
    const char* cA = (const char*)g.A + (size_t)cur.pm * tstep; const char* cB = (const char*)g.Bt + (size_t)cur.pn * tstep;
    S.a_ready(cur);
    if constexpr (SP2) {
        PG8_STAGE(PG8_SB(0, 0), cB, voffB); PG8_STAGE(PG8_SB(0, 1), cB + hstep, voffB); PG8_STAGE(PG8_SA(0, 0), cA, voffA); PG8_STAGE(PG8_SA(0, 1), cA + hstep, voffA);
        if (wr == 1) PG8_BAR;
        PG8_WAIT_V(2); PG8_BAR;
        PG8_STAGE(PG8_SB(1, 0), cB + kstep, voffB); PG8_STAGE(PG8_SA(1, 0), cA + kstep, voffA); PG8_STAGE(PG8_SB(1, 1), cB + hstep + kstep, voffB);
        PG8_WAIT_V(6); PG8_BAR;
    } else {
        PG8_STAGE(PG8_SB(0, 0), cB, voffB); PG8_STAGE(PG8_SA(0, 0), cA, voffA); PG8_STAGE(PG8_SB(0, 1), cB + hstep, voffB); PG8_STAGE(PG8_SA(0, 1), cA + hstep, voffA);
        if (wr == 1) PG8_BAR;
        PG8_WAIT_V(4); PG8_BAR;
        PG8_STAGE(PG8_SB(1, 0), cB + kstep, voffB); PG8_STAGE(PG8_SA(1, 0), cA + kstep, voffA); PG8_STAGE(PG8_SB(1, 1), cB + hstep + kstep, voffB);
        PG8_WAIT_V(6); PG8_BAR;
    }
    for (;;) {
        const bool has_next = S.next(ui + 1, nxt);
        const char* nA = has_next ? (const char*)g.A + (size_t)nxt.pm * tstep : cA; const char* nB = has_next ? (const char*)g.Bt + (size_t)nxt.pn * tstep : cB;
        for (int t = 0; t < nt; t += 2) {
            const bool last = (t == nt - 2);
            const char* a1 = cA + (size_t)(t + 1) * kstep;
            const char* a2 = last ? nA : cA + (size_t)(t + 2) * kstep; const char* b2 = last ? nB : cB + (size_t)(t + 2) * kstep;
            const char* a3 = a2 + kstep; const char* b3 = b2 + kstep;
            if (last && has_next) S.a_ready(nxt);
            if constexpr (SP2) {
            PG8_LDB(B0, 0, 0); PG8_LDB(B1, 0, 1); PG8_SCHED; PG8_LDA(At, 0, 0); PG8_STAGE(PG8_SA(1, 1), a1 + hstep, voffA);
            PG8_WAIT_V(8); PG8_WAIT_L(0); PG8_BAR; PG8_MMA(0, 0, At, B0); PG8_MMA(0, 1, At, B1); PG8_BAR; PG8_SCHED;
            PG8_LDA(At, 0, 1); PG8_STAGE(PG8_SB(0, 0), b2, voffB); PG8_STAGE(PG8_SB(0, 1), b2 + hstep, voffB); PG8_STAGE(PG8_SA(0, 0), a2, voffA);
            PG8_WAIT_V(8); PG8_WAIT_L(0); PG8_BAR; PG8_MMA(1, 0, At, B0); PG8_MMA(1, 1, At, B1); PG8_BAR; PG8_SCHED;
            PG8_LDB(B0, 1, 0); PG8_LDB(B1, 1, 1); PG8_SCHED; PG8_LDA(At, 1, 0); PG8_STAGE(PG8_SA(0, 1), a2 + hstep, voffA);
            PG8_WAIT_V(8); PG8_WAIT_L(0); PG8_BAR; PG8_MMA(0, 0, At, B0); PG8_MMA(0, 1, At, B1); PG8_BAR; PG8_SCHED;
            PG8_LDA(At, 1, 1); PG8_STAGE(PG8_SB(1, 0), b3, voffB); PG8_STAGE(PG8_SB(1, 1), b3 + hstep, voffB); PG8_STAGE(PG8_SA(1, 0), a3, voffA);
            PG8_WAIT_V(8); PG8_WAIT_L(0); PG8_BAR; PG8_MMA(1, 0, At, B0); PG8_MMA(1, 1, At, B1); PG8_BAR; PG8_SCHED;
            } else {
            PG8_LDB(B0, 0, 0); PG8_SCHED; PG8_LDA(At, 0, 0); PG8_STAGE(PG8_SA(1, 1), a1 + hstep, voffA);
            PG8_WAIT_L(8); PG8_BAR; PG8_WAIT_L(0); PG8_MMA(0, 0, At, B0); PG8_BAR; PG8_SCHED;
            PG8_LDB(B1, 0, 1); PG8_STAGE(PG8_SB(0, 0), b2, voffB);
            PG8_BAR; PG8_WAIT_L(0); PG8_MMA(0, 1, At, B1); PG8_BAR;
            PG8_LDA(At, 0, 1); PG8_STAGE(PG8_SA(0, 0), a2, voffA);
            PG8_BAR; PG8_WAIT_L(0); PG8_MMA(1, 0, At, B0); PG8_BAR; PG8_SCHED;
            PG8_STAGE(PG8_SB(0, 1), b2 + hstep, voffB);
            PG8_WAIT_V(6); PG8_BAR; PG8_MMA(1, 1, At, B1); PG8_BAR;
            PG8_LDB(B0, 1, 0); PG8_SCHED; PG8_LDA(At, 1, 0); PG8_STAGE(PG8_SA(0, 1), a2 + hstep, voffA);
            PG8_WAIT_L(8); PG8_BAR; PG8_WAIT_L(0); PG8_MMA(0, 0, At, B0); PG8_BAR; PG8_SCHED;
            PG8_LDB(B1, 1, 1); PG8_STAGE(PG8_SB(1, 0), b3, voffB);
            PG8_BAR; PG8_WAIT_L(0); PG8_MMA(0, 1, At, B1); PG8_BAR;
            PG8_LDA(At, 1, 1); PG8_STAGE(PG8_SA(1, 0), a3, voffA);
            PG8_BAR; PG8_WAIT_L(0); PG8_MMA(1, 0, At, B0); PG8_BAR; PG8_SCHED;
            PG8_STAGE(PG8_SB(1, 1), b3 + hstep, voffB);
            PG8_WAIT_V(6); PG8_BAR; PG8_MMA(1, 1, At, B1); PG8_BAR;
            }
        }
        if constexpr (ALIGN_EPI) { if (wr == 0) PG8_BAR; }
        if constexpr (!Epi::AFTER_DRAIN) { E(acc, cur, wr, wc, fr, fq); S.done(cur); }
        if (!has_next) break;
#pragma unroll
        for (int a = 0; a < 2; ++a)
#pragma unroll
            for (int b = 0; b < 2; ++b)
#pragma unroll
                for (int m = 0; m < 4; ++m)
#pragma unroll
                    for (int n = 0; n < 2; ++n) acc[a][b][m][n] = (f32x4){0.f, 0.f, 0.f, 0.f};
        cur = nxt; cA = nA; cB = nB; ++ui;
        if constexpr (ALIGN_EPI) { if (wr == 1) PG8_BAR; }
    }
    PG8_WAIT_V(0);
    if constexpr (!ALIGN_EPI) { if (wr == 0) PG8_BAR; }
    PG8_BAR;
    if constexpr (Epi::AFTER_DRAIN) { E.fused(acc, cur, wr, wc, fr, fq, lds, wid, lane); S.done(cur); }
#undef PG8_SA
#undef PG8_SB
#undef PG8_STAGE
#undef PG8_LDA
#undef PG8_LDB
#undef PG8_MMA
#undef PG8_WAIT_V
#undef PG8_WAIT_L
#undef PG8_BAR
#undef PG8_SCHED
}
}
#define GAS __attribute__((address_space(1)))
#define LAS __attribute__((address_space(3)))
typedef unsigned short bf16;
typedef unsigned v4u __attribute__((ext_vector_type(4)));
typedef float f32x4 __attribute__((ext_vector_type(4)));
typedef short bf16x8 __attribute__((ext_vector_type(8)));
typedef GAS unsigned gu32;
typedef GAS unsigned long long gu64;
#define RLX_AGENT __ATOMIC_RELAXED, __HIP_MEMORY_SCOPE_AGENT
#define LDS_WAIT() asm volatile("s_waitcnt lgkmcnt(0)" ::: "memory")
#define VM_WAIT() asm volatile("s_waitcnt vmcnt(0)" ::: "memory")
__device__ __forceinline__ unsigned long long rt() { return __builtin_amdgcn_s_memrealtime(); }
__device__ __forceinline__ unsigned f2bf(float f) { unsigned u = __builtin_bit_cast(unsigned, f); return (u + 0x7fffu + ((u >> 16) & 1u)) >> 16; }
__device__ __forceinline__ unsigned pk2(float lo, float hi) { return f2bf(lo) | (f2bf(hi) << 16); }
#define XB_TMO      128
#define XB_XCNT(j)  (256  + 64 * (j))
#define XB_XSUB(j)  (1280 + 64 * (j))
#define XB_XGEN(j)  (2304 + 64 * (j))
#define XB_TOP      3328
#define XB_TOPGEN   3392
#define XCD_BAR_WORDS 3456
#define XB_SPIN_CAP (1u << 18)

__device__ __forceinline__ unsigned xb_ld(unsigned* p)              { return __hip_atomic_load(p, __ATOMIC_RELAXED, __HIP_MEMORY_SCOPE_AGENT); }
__device__ __forceinline__ unsigned xb_add(unsigned* p, unsigned v) { return __hip_atomic_fetch_add(p, v, __ATOMIC_RELAXED, __HIP_MEMORY_SCOPE_AGENT); }
__device__ __forceinline__ unsigned xb_xcc_id() { return (unsigned)__builtin_amdgcn_s_getreg((3 << 11) | 20) & 0xFu; }
#define XB_SPIN(cond, bar) do { unsigned _sp = 0; while (cond) { __builtin_amdgcn_s_sleep(1); \
    if ((++_sp & 255u) == 0u) { if (xb_ld(&(bar)[XB_TMO])) break; if (_sp > XB_SPIN_CAP) { atomicAdd(&(bar)[XB_TMO], 1u); break; } } } } while (0)

struct XcdBarrier {
    unsigned* bar; unsigned x;
    volatile LAS unsigned* st;
};

__device__ __forceinline__ XcdBarrier xcd_barrier_post(unsigned* bar, volatile LAS unsigned* st) {
    XcdBarrier b; b.bar = bar; b.x = xb_xcc_id(); b.st = st;
    if (threadIdx.x == 0) (void)xb_add(&bar[XB_XCNT(b.x)], 1u);
    return b;
}
__device__ __forceinline__ void xcd_barrier_complete(unsigned* bar, unsigned x, unsigned& nloc, unsigned& nx) {
    const unsigned G = gridDim.x * gridDim.y * gridDim.z;
    unsigned sum, cnt, mine, sp = 0u;
    for (;;) {
        sum = 0u; cnt = 0u; mine = 0u;
#pragma unroll
        for (unsigned j = 0; j < 16; ++j) { const unsigned c = xb_ld(&bar[XB_XCNT(j)]); sum += c; cnt += (c > 0u) ? 1u : 0u; mine = (j == x) ? c : mine; }
        if (sum == G) break;
        __builtin_amdgcn_s_sleep(1);
        if ((++sp & 255u) == 0u) { if (xb_ld(&bar[XB_TMO])) break; if (sp > XB_SPIN_CAP) { atomicAdd(&bar[XB_TMO], 1u); break; } }
    }
    nloc = mine > 0u ? mine : 1u; nx = cnt > 0u ? cnt : 1u;
}

__device__ __forceinline__ void xcd_barrier(const XcdBarrier& b) {
    asm volatile("s_waitcnt vmcnt(0)" ::: "memory");
    __syncthreads();
    if (threadIdx.x == 0) {
        unsigned* bar = b.bar;
        __builtin_amdgcn_s_waitcnt(0);
        unsigned nloc = b.st[0], nx = b.st[1];
        if (nloc == 0u) { xcd_barrier_complete(bar, b.x, nloc, nx); b.st[0] = nloc; b.st[1] = nx; }
        const unsigned old = xb_add(&bar[XB_XSUB(b.x)], 1u);
        const unsigned gen = old / nloc;
        if (old + 1u == (gen + 1u) * nloc) {
            __builtin_amdgcn_fence(__ATOMIC_RELEASE, "agent");
            asm volatile("s_waitcnt vmcnt(0)" ::: "memory");
            const unsigned og = xb_add(&bar[XB_TOP], 1u);
            const unsigned tg = og / nx;
            if (og + 1u == (tg + 1u) * nx) xb_add(&bar[XB_TOPGEN], 1u);
            else XB_SPIN(xb_ld(&bar[XB_TOPGEN]) == tg, bar);
            __builtin_amdgcn_fence(__ATOMIC_ACQUIRE, "agent");
            xb_add(&bar[XB_XGEN(b.x)], 1u);
            asm volatile("s_waitcnt vmcnt(0)" ::: "memory");
        } else {
            XB_SPIN(xb_ld(&bar[XB_XGEN(b.x)]) == gen, bar);
            __builtin_amdgcn_fence(__ATOMIC_ACQUIRE, "agent");
            asm volatile("s_waitcnt vmcnt(0)" ::: "memory");
        }
    }
    __syncthreads();
}
constexpr int NWAVES = 8;
constexpr int D = 1024, DIN = 2048, DR = 512, DC = 512, FF = 4096, NH = 8, HD = 64;
constexpr int NB = 4, SEQ = 4096, NMETA = 16, SB = 8, SS = 64;
constexpr int M_PROMPT = NB * SEQ;
constexpr int M_SAMPLE = SB * SS;
constexpr int M_MAIN = M_PROMPT + M_SAMPLE;
constexpr int ROW_META = M_MAIN;
constexpr int M_Z = 67 * 256;
constexpr float EPS = 1e-6f;
constexpr int ZCOLS = 512;
constexpr size_t O_Y = 0;
constexpr size_t O_CONV_P = (size_t)M_MAIN * D;
constexpr size_t O_H_P = O_CONV_P + NB * 3 * DR;
constexpr size_t O_DW_P = O_H_P + NB * DR;
constexpr size_t O_CONV_S = O_DW_P + NB * 30 * DC;
constexpr size_t O_H_S = O_CONV_S + SB * 3 * DR;
constexpr size_t O_DW_S = O_H_S + SB * DR;
constexpr size_t O_END = O_DW_S + SB * 30 * DC;
static_assert(O_END == 17510400, "d_out size");
constexpr size_t MiB = 1u << 20;
constexpr size_t WS_CTL = 0, CTL_ZERO_BYTES = 64 * 1024;
constexpr size_t WS_W1 = 2 * MiB, WS_WO = 6 * MiB, WS_WUP = 8 * MiB, WS_WDN = 16 * MiB;
constexpr size_t WS_WG = 24 * MiB;
constexpr size_t WS_LU = WS_WG + 256 * 1024;
constexpr size_t WS_AGG = 25 * MiB;
constexpr size_t WS_SSQ1 = 27 * MiB, WS_SSQ2 = 29 * MiB;
constexpr size_t WS_X1B = 32 * MiB;
constexpr size_t WS_HN = 66 * MiB;
constexpr size_t WS_XR = 100 * MiB, WS_GG = 117 * MiB, WS_V = 134 * MiB;
constexpr size_t WS_MIX = 151 * MiB;
constexpr size_t WS_U = 66 * MiB;
constexpr size_t WS_END = 198 * MiB;
static_assert(WS_AGG + 265 * 512 * 8 <= WS_SSQ1 && WS_SSQ1 + (size_t)M_MAIN * 64 <= WS_SSQ2 && WS_SSQ2 + (size_t)M_MAIN * 64 <= WS_X1B, "ws map 1");
static_assert(WS_X1B + (size_t)M_MAIN * D * 2 <= WS_HN && WS_HN + (size_t)M_Z * D * 2 <= WS_XR && WS_XR + (size_t)M_Z * 512 * 2 <= WS_GG && WS_GG + (size_t)M_Z * 512 * 2 <= WS_V && WS_V + (size_t)M_Z * 512 * 2 <= WS_MIX, "ws map 2");
static_assert(WS_MIX + (size_t)M_MAIN * D * 2 <= WS_END && WS_U + (size_t)M_MAIN * FF * 2 <= WS_END, "ws map 3");
constexpr int CW_BAR = 4096;
static_assert((CW_BAR + 3456) * 4 <= (int)CTL_ZERO_BYTES, "CTL");
constexpr int RING_BYTES = 131072;
constexpr int MISC_OFF = RING_BYTES;
constexpr int LDS_BYTES = RING_BYTES + 256;

typedef unsigned u32x2v __attribute__((ext_vector_type(2)));
typedef float f32x2v __attribute__((ext_vector_type(2)));
__device__ __forceinline__ float bf_lo(unsigned u) { return __builtin_bit_cast(float, u << 16); }
__device__ __forceinline__ float bf_hi(unsigned u) { return __builtin_bit_cast(float, u & 0xffff0000u); }
__device__ __forceinline__ float sigm(float x) { return __builtin_amdgcn_rcpf(1.0f + __builtin_amdgcn_exp2f(-1.4426950408889634f * x)); }

struct Frame {
    LAS unsigned char* lds;
    int tid, lane, wave, G, bid;
    const float *x_prompt, *x_sample, *st_conv, *st_h, *st_dw, *meta, *norm_mix, *w_in, *cw, *cb, *wgr, *bgr, *wgi, *bgi, *lam, *dww, *dwb, *lng, *lnb, *onr, *onc, *w_out, *norm_mlp, *w_up, *w_down, *norm_final;
    float* out;
    bf16 *W1t, *Wot, *Wupt, *Wdt, *Wg, *HN, *XR, *GG, *V, *MIX, *X1B, *U;
    float *LU, *AGG, *SSQ1, *SSQ2;
};

__device__ __forceinline__ float wave_sum(float v) {
#pragma unroll
    for (int o = 1; o < 64; o <<= 1) v += __shfl_xor(v, o);
    return v;
}
__device__ __forceinline__ void p0_transpose_item(const float* W, int K, int N, bf16* WT, const float* gain, LAS float* scr, int k0, int n0, int dest_row0, int lane) {
#pragma unroll 8
    for (int i = 0; i < 32; ++i) { const int kk = 2 * i + (lane >> 5); float w = W[(size_t)(k0 + kk) * N + n0 + (lane & 31)]; if (gain) w *= gain[k0 + kk]; scr[kk * 33 + (lane & 31)] = w; }
    LDS_WAIT(); asm volatile("" ::: "memory");
    const int c = lane & 7;
#pragma unroll
    for (int j = 0; j < 4; ++j) { const int n = (lane >> 3) + 8 * j; const LAS float* s = scr + (8 * c) * 33 + n;
        v4u o; o.x = pk2(s[0 * 33], s[1 * 33]); o.y = pk2(s[2 * 33], s[3 * 33]); o.z = pk2(s[4 * 33], s[5 * 33]); o.w = pk2(s[6 * 33], s[7 * 33]);
        *(GAS v4u*)(WT + (size_t)(dest_row0 + n) * K + k0 + 8 * c) = o; }
    LDS_WAIT(); asm volatile("" ::: "memory");
}
__device__ __forceinline__ int w1_dest_row(int n0) {
    if (n0 < 1024) return n0;
    if (n0 < 1536) { const int q = (n0 - 1024) >> 7, tc = (n0 - 1024) & 127; return 1024 + 256 * q + tc; }
    { const int q = (n0 - 1536) >> 7, tc = (n0 - 1536) & 127; return 1024 + 256 * q + 128 + tc; }
}
__device__ __forceinline__ void p0_prologue(Frame& F) {
    LAS float* scr = (LAS float*)(F.lds + F.wave * 16384);
    const int gw = F.bid * NWAVES + F.wave, NGW = F.G * NWAVES, lane = F.lane;
    constexpr int I_1 = (D / 64) * (DIN / 32), I_O = (D / 64) * (D / 32), I_U = (D / 64) * (FF / 32), I_D = (FF / 64) * (D / 32);
    constexpr int NITEMS = I_1 + I_O + I_U + I_D;
    for (int it = gw; it < NITEMS; it += NGW) {
        int r = it;
        if (r < I_1) { const int nblk = DIN / 32, kb = r / nblk, nb = r % nblk; p0_transpose_item(F.w_in, D, DIN, F.W1t, nullptr, scr, 64 * kb, 32 * nb, w1_dest_row(32 * nb), lane); continue; } r -= I_1;
        if (r < I_O) { const int nblk = D / 32, kb = r / nblk, nb = r % nblk; p0_transpose_item(F.w_out, D, D, F.Wot, nullptr, scr, 64 * kb, 32 * nb, 32 * nb, lane); continue; } r -= I_O;
        if (r < I_U) { const int nblk = FF / 32, kb = r / nblk, nb = r % nblk; p0_transpose_item(F.w_up, D, FF, F.Wupt, F.norm_mlp, scr, 64 * kb, 32 * nb, 32 * nb, lane); continue; } r -= I_U;
        { const int nblk = D / 32, kb = r / nblk, nb = r % nblk; p0_transpose_item(F.w_down, FF, D, F.Wdt, nullptr, scr, 64 * kb, 32 * nb, 32 * nb, lane); }
    }
    const int gt = F.bid * (NWAVES * 64) + F.tid, NGT = F.G * NWAVES * 64;
    for (int i = gt; i < 2 * NH * HD * HD; i += NGT) { const int g = i >> 15, h = (i >> 12) & 7, e = (i >> 6) & 63, d = i & 63; const float* src = g ? F.wgi : F.wgr; F.Wg[i] = (bf16)f2bf(src[(h * 64 + d) * 64 + e]); }
    for (int i = gt; i < DR; i += NGT) F.LU[i] = -8.0f * log1pf(expf(-F.lam[i]));
    for (int m = gw; m < M_Z; m += NGW) {
        GAS unsigned long long* o8 = (GAS unsigned long long*)(F.HN + (size_t)m * D) + lane;
        if (m >= ROW_META + NMETA) {
#pragma unroll
            for (int j = 0; j < 4; ++j) o8[64 * j] = 0ull;
            continue; }
        const float* xrow = m < M_PROMPT ? F.x_prompt + (size_t)m * D : (m < M_MAIN ? F.x_sample + (size_t)(m - M_PROMPT) * D : F.meta + (size_t)(m - ROW_META) * D);
        const GAS f32x4* xr = (const GAS f32x4*)xrow + lane; const GAS f32x4* gr = (const GAS f32x4*)F.norm_mix + lane;
        f32x4 v[4]; float s = 0.f;
#pragma unroll
        for (int j = 0; j < 4; ++j) { v[j] = xr[64 * j]; s += (v[j].x * v[j].x + v[j].y * v[j].y) + (v[j].z * v[j].z + v[j].w * v[j].w); }
        const float rinv = 1.0f / sqrtf(wave_sum(s) * (1.f / D) + EPS);
#pragma unroll
        for (int j = 0; j < 4; ++j) { const f32x4 g = gr[64 * j]; const f32x4 y = v[j] * rinv * g; o8[64 * j] = (unsigned long long)pk2(y.x, y.y) | ((unsigned long long)pk2(y.z, y.w) << 32); }
    }
}
struct SeqUnit { int kind, b, row0, t0, ntb, j; };
__device__ __forceinline__ SeqUnit seq_unit(int id) {
    SeqUnit u;
    if (id < 256) { u.kind = 0; u.b = id >> 6; u.j = id & 63; u.row0 = u.b * SEQ; u.t0 = 64 * u.j; u.ntb = 4; }
    else if (id < 264) { u.kind = 1; u.b = id - 256; u.j = 0; u.row0 = M_PROMPT + SS * u.b; u.t0 = 0; u.ntb = 4; }
    else { u.kind = 2; u.b = 0; u.j = 0; u.row0 = ROW_META; u.t0 = 0; u.ntb = 1; }
    return u;
}
__device__ __forceinline__ void xr_load4(const Frame& F, const SeqUnit& u, int s, int c, float (&o)[4]) {
    if (s >= 0 || u.kind == 0) {
        const size_t row = s >= 0 ? (size_t)(u.row0 + s) : (size_t)(ROW_META + NMETA + s);
        const u32x2v w = *(const u32x2v*)(F.XR + row * ZCOLS + c); o[0] = bf_lo(w.x); o[1] = bf_hi(w.x); o[2] = bf_lo(w.y); o[3] = bf_hi(w.y);
    } else if (u.kind == 1) { const f32x4 v = *(const f32x4*)(F.st_conv + (size_t)(u.b * 3 + 3 + s) * DR + c); o[0] = v.x; o[1] = v.y; o[2] = v.z; o[3] = v.w; }
    else { o[0] = 0.f; o[1] = 0.f; o[2] = 0.f; o[3] = 0.f; }
}
__device__ __forceinline__ void xr_load8(const Frame& F, const SeqUnit& u, int s, int c, float (&o)[8]) {
    if (s >= 0 || u.kind == 0) {
        const size_t row = s >= 0 ? (size_t)(u.row0 + s) : (size_t)(ROW_META + NMETA + s);
        const v4u w = *(const v4u*)(F.XR + row * ZCOLS + c);
        o[0] = bf_lo(w.x); o[1] = bf_hi(w.x); o[2] = bf_lo(w.y); o[3] = bf_hi(w.y); o[4] = bf_lo(w.z); o[5] = bf_hi(w.z); o[6] = bf_lo(w.w); o[7] = bf_hi(w.w);
    } else if (u.kind == 1) { const float* p = F.st_conv + (size_t)(u.b * 3 + 3 + s) * DR + c; const f32x4 a = *(const f32x4*)p, b = *(const f32x4*)(p + 4);
        o[0] = a.x; o[1] = a.y; o[2] = a.z; o[3] = a.w; o[4] = b.x; o[5] = b.y; o[6] = b.z; o[7] = b.w; }
    else {
#pragma unroll
        for (int j = 0; j < 8; ++j) o[j] = 0.f; }
}
__device__ __forceinline__ float dpp_shr(float v, float ident, int sh) {
    int r;
    switch (sh) {
        case 1: r = __builtin_amdgcn_update_dpp(__builtin_bit_cast(int, ident), __builtin_bit_cast(int, v), 0x111, 0xF, 0xF, false); break;
        case 2: r = __builtin_amdgcn_update_dpp(__builtin_bit_cast(int, ident), __builtin_bit_cast(int, v), 0x112, 0xF, 0xF, false); break;
        case 4: r = __builtin_amdgcn_update_dpp(__builtin_bit_cast(int, ident), __builtin_bit_cast(int, v), 0x114, 0xF, 0xF, false); break;
        default: r = __builtin_amdgcn_update_dpp(__builtin_bit_cast(int, ident), __builtin_bit_cast(int, v), 0x118, 0xF, 0xF, false); break;
    }
    return __builtin_bit_cast(float, r);
}
template <bool PASSB>
__device__ __forceinline__ void rnn_block(const Frame& F, const SeqUnit& u, int tb, float (&H)[4][4], float (&Pc)[4][4]) {
    const int h = F.wave, lane = F.lane; int fr = lane & 15, fq = lane >> 4;
    asm volatile("" : "+v"(fr), "+v"(fq));
    const int s = u.t0 + 16 * tb + fr;
    bf16x8 Xf[2];
#pragma unroll
    for (int ks = 0; ks < 2; ++ks) {
        const int c8 = 64 * h + 32 * ks + 8 * fq; float a8[8];
        { const f32x4 b0 = *(const f32x4*)(F.cb + c8), b1 = *(const f32x4*)(F.cb + c8 + 4); a8[0] = b0.x; a8[1] = b0.y; a8[2] = b0.z; a8[3] = b0.w; a8[4] = b1.x; a8[5] = b1.y; a8[6] = b1.z; a8[7] = b1.w; }
#pragma unroll
        for (int k = 0; k < 4; ++k) { float x8[8]; xr_load8(F, u, s - 3 + k, c8, x8); const f32x4 w0 = *(const f32x4*)(F.cw + k * DR + c8), w1 = *(const f32x4*)(F.cw + k * DR + c8 + 4);
            a8[0] += w0.x * x8[0]; a8[1] += w0.y * x8[1]; a8[2] += w0.z * x8[2]; a8[3] += w0.w * x8[3]; a8[4] += w1.x * x8[4]; a8[5] += w1.y * x8[5]; a8[6] += w1.z * x8[6]; a8[7] += w1.w * x8[7]; }
        v4u pk; pk.x = pk2(a8[0], a8[1]); pk.y = pk2(a8[2], a8[3]); pk.z = pk2(a8[4], a8[5]); pk.w = pk2(a8[6], a8[7]);
        Xf[ks] = __builtin_bit_cast(bf16x8, pk);
        asm volatile("" ::: "memory");
    }
    float ssq = 0.f;
    bf16* orow = F.MIX + (size_t)(u.row0 + s) * D;
#pragma unroll
    for (int eb = 0; eb < 4; ++eb) {
        asm volatile("" ::: "memory");
        const bf16* wp = F.Wg + ((size_t)h * HD + 16 * eb + fr) * HD + 8 * fq;
        const bf16x8 Wr0 = *(const bf16x8*)wp, Wr1 = *(const bf16x8*)(wp + 32), Wi0 = *(const bf16x8*)(wp + NH * HD * HD), Wi1 = *(const bf16x8*)(wp + NH * HD * HD + 32);
        f32x4 ar = {0.f, 0.f, 0.f, 0.f}, ai = {0.f, 0.f, 0.f, 0.f};
        ar = __builtin_amdgcn_mfma_f32_16x16x32_bf16(Wr0, Xf[0], ar, 0, 0, 0); ar = __builtin_amdgcn_mfma_f32_16x16x32_bf16(Wr1, Xf[1], ar, 0, 0, 0);
        ai = __builtin_amdgcn_mfma_f32_16x16x32_bf16(Wi0, Xf[0], ai, 0, 0, 0); ai = __builtin_amdgcn_mfma_f32_16x16x32_bf16(Wi1, Xf[1], ai, 0, 0, 0);
        const int c4 = 64 * h + 16 * eb + 4 * fq;
        float xc[4]; { const f32x4 b0 = *(const f32x4*)(F.cb + c4); xc[0] = b0.x; xc[1] = b0.y; xc[2] = b0.z; xc[3] = b0.w; }
#pragma unroll
        for (int k = 0; k < 4; ++k) { float x4[4]; xr_load4(F, u, s - 3 + k, c4, x4); const f32x4 w0 = *(const f32x4*)(F.cw + k * DR + c4);
            xc[0] += w0.x * x4[0]; xc[1] += w0.y * x4[1]; xc[2] += w0.z * x4[2]; xc[3] += w0.w * x4[3]; }
        const f32x4 br = *(const f32x4*)(F.bgr + c4), bi = *(const f32x4*)(F.bgi + c4), lu = *(const f32x4*)(F.LU + c4);
        float gg[4] = {0.f, 0.f, 0.f, 0.f}; f32x4 og = {0.f, 0.f, 0.f, 0.f};
        if (PASSB) { const u32x2v w = *(const u32x2v*)(F.GG + (size_t)(u.row0 + s) * ZCOLS + c4); gg[0] = bf_lo(w.x); gg[1] = bf_hi(w.x); gg[2] = bf_lo(w.y); gg[3] = bf_hi(w.y); og = *(const f32x4*)(F.onr + c4); }
        float y[4];
#pragma unroll
        for (int r = 0; r < 4; ++r) {
            const float rg = sigm(ar[r] + br[r]), ig = sigm(ai[r] + bi[r]);
            float A = __builtin_amdgcn_exp2f(1.4426950408889634f * rg * lu[r]);
            float B = sqrtf(fmaxf(1.0f - A * A, 0.f)) * ig * xc[r];
#pragma unroll
            for (int sh = 1; sh < 16; sh <<= 1) { const float Ap = dpp_shr(A, 1.0f, sh), Bp = dpp_shr(B, 0.0f, sh); B = A * Bp + B; A = A * Ap; }
            const float hl = A * H[eb][r] + B;
            H[eb][r] = __shfl(hl, (lane & 48) | 15);
            if (!PASSB) Pc[eb][r] *= __shfl(A, (lane & 48) | 15);
            if (PASSB) { y[r] = hl * gg[r]; ssq += y[r] * y[r]; }
        }
        if (PASSB) { u32x2v w; w.x = pk2(y[0] * og[0], y[1] * og[1]); w.y = pk2(y[2] * og[2], y[3] * og[3]); *(u32x2v*)(orow + c4) = w; }
    }
    if (PASSB) { LAS float* red = (LAS float*)F.lds; ssq += __shfl_xor(ssq, 16); ssq += __shfl_xor(ssq, 32); if (fq == 0) red[(16 * tb + fr) * 8 + h] = ssq; }
}
template <bool PASSB>
__device__ __forceinline__ void rnn_unit(Frame& F, int uid) {
    const SeqUnit u = seq_unit(uid);
    const int h = F.wave, lane = F.lane, fr = lane & 15, fq = lane >> 4;
    float H[4][4], Pc[4][4];
#pragma unroll
    for (int eb = 0; eb < 4; ++eb)
#pragma unroll
        for (int r = 0; r < 4; ++r) { H[eb][r] = 0.f; Pc[eb][r] = 1.f; }
    if (PASSB) {
        if (u.kind == 1) {
#pragma unroll
            for (int eb = 0; eb < 4; ++eb) { const f32x4 v = *(const f32x4*)(F.st_h + (size_t)u.b * DR + 64 * h + 16 * eb + 4 * fq); H[eb][0] = v.x; H[eb][1] = v.y; H[eb][2] = v.z; H[eb][3] = v.w; }
        } else {
#pragma unroll
            for (int eb = 0; eb < 4; ++eb) { const float* p = F.AGG + ((size_t)264 * DR + 64 * h + 16 * eb + 4 * fq) * 2; const f32x4 a = *(const f32x4*)p, b = *(const f32x4*)(p + 4); H[eb][0] = a.y; H[eb][1] = a.w; H[eb][2] = b.y; H[eb][3] = b.w; }
#pragma unroll 1
            for (int jj = 0; jj < u.j; ++jj) {
#pragma unroll
                for (int eb = 0; eb < 4; ++eb) { const float* p = F.AGG + ((size_t)(u.b * 64 + jj) * DR + 64 * h + 16 * eb + 4 * fq) * 2; const f32x4 a = *(const f32x4*)p, b = *(const f32x4*)(p + 4);
                    H[eb][0] = a.x * H[eb][0] + a.y; H[eb][1] = a.z * H[eb][1] + a.w; H[eb][2] = b.x * H[eb][2] + b.y; H[eb][3] = b.z * H[eb][3] + b.w; }
            }
        }
    }
#pragma unroll 1
    for (int tb = 0; tb < u.ntb; ++tb) rnn_block<PASSB>(F, u, tb, H, Pc);
    if (!PASSB) {
        if (fr == 0) {
#pragma unroll
            for (int eb = 0; eb < 4; ++eb) { float* p = F.AGG + ((size_t)uid * DR + 64 * h + 16 * eb + 4 * fq) * 2;
                *(f32x4*)p = (f32x4){Pc[eb][0], H[eb][0], Pc[eb][1], H[eb][1]}; *(f32x4*)(p + 4) = (f32x4){Pc[eb][2], H[eb][2], Pc[eb][3], H[eb][3]}; }
        }
    } else {
        LAS float* red = (LAS float*)F.lds;
        __syncthreads();
#pragma unroll 1
        for (int tb = 0; tb < 4; ++tb) {
            const LAS f32x4* rp = (const LAS f32x4*)(red + (16 * tb + fr) * 8); const f32x4 a = rp[0], b = rp[1];
            const float rinv = 1.0f / sqrtf(((a.x + a.y) + (a.z + a.w) + (b.x + b.y) + (b.z + b.w)) * (1.0f / DR) + EPS);
            bf16* orow = F.MIX + (size_t)(u.row0 + u.t0 + 16 * tb + fr) * D + 64 * h + 4 * fq;
#pragma unroll
            for (int eb = 0; eb < 4; ++eb) { u32x2v w = *(u32x2v*)(orow + 16 * eb);
                w.x = pk2(bf_lo(w.x) * rinv, bf_hi(w.x) * rinv); w.y = pk2(bf_lo(w.y) * rinv, bf_hi(w.y) * rinv); *(u32x2v*)(orow + 16 * eb) = w; }
        }
        if (fr == 0 && (u.kind == 1 || u.j == 63)) {
            float* ho = F.out + (u.kind == 1 ? O_H_S : O_H_P) + (size_t)u.b * DR;
#pragma unroll
            for (int eb = 0; eb < 4; ++eb) *(f32x4*)(ho + 64 * h + 16 * eb + 4 * fq) = (f32x4){H[eb][0], H[eb][1], H[eb][2], H[eb][3]};
        }
        __syncthreads();
    }
}
template <int N> __device__ __forceinline__ float xreduce(float (&v)[N], int lane) {
#pragma unroll
    for (int half = N / 2, off = 32; half >= 1; half >>= 1, off >>= 1) {
        const bool up = (lane & off) != 0;
#pragma unroll
        for (int i = 0; i < half; ++i) { const float send = up ? v[i] : v[i + half], keep = up ? v[i + half] : v[i]; v[i] = keep + __shfl_xor(send, off); }
    }
    float r = v[0];
#pragma unroll
    for (int off = 32 / N; off >= 1; off >>= 1) r += __shfl_xor(r, off);
    return r;
}
__device__ __forceinline__ void conv_unit(Frame& F, int uid) {
    const SeqUnit u = seq_unit(uid);
    const int lane = F.lane, tg = F.wave >> 2, cg = F.wave & 3, c0_ = 128 * cg + 2 * lane;
    LAS float* red1 = (LAS float*)(F.lds);
    LAS float* red2 = (LAS float*)(F.lds + 512);
    LAS unsigned char* vt = F.lds + 8192;
#pragma unroll 1
    for (int r = F.wave; r < 94; r += NWAVES) {
        const int s = u.t0 - 30 + r; v4u val = {0u, 0u, 0u, 0u};
        if (s >= 0) val = *(const v4u*)(F.V + (size_t)(u.row0 + s) * ZCOLS + 8 * lane);
        else if (u.kind == 0) { if (NMETA + s >= 0) val = *(const v4u*)(F.V + (size_t)(ROW_META + NMETA + s) * ZCOLS + 8 * lane); }
        else { const float* p = F.st_dw + (size_t)(u.b * 30 + 30 + s) * DC + 8 * lane; const f32x4 a = *(const f32x4*)p, b = *(const f32x4*)(p + 4);
            val.x = pk2(a.x, a.y); val.y = pk2(a.z, a.w); val.z = pk2(b.x, b.y); val.w = pk2(b.z, b.w); }
        *(LAS v4u*)(vt + r * 1024 + 16 * lane) = val;
    }
    f32x2v w[31];
    unsigned cb4 = (unsigned)c0_ * 4u; asm volatile("" : "+v"(cb4));
#pragma unroll
    for (int k = 0; k < 31; ++k) w[k] = *(const f32x2v*)((const char*)(F.dww + k * DC) + cb4);
    const f32x2v bias = *(const f32x2v*)((const char*)F.dwb + cb4), lg = *(const f32x2v*)((const char*)F.lng + cb4), lb = *(const f32x2v*)((const char*)F.lnb + cb4), og = *(const f32x2v*)((const char*)F.onc + cb4);
    __syncthreads();
#pragma unroll 1
    for (int bb = 0; bb < 4; ++bb) {
        const int rb = 32 * tg + 8 * bb;
        const int tb0 = u.t0 + rb;
        int c0 = c0_; asm volatile("" : "+v"(c0));
        f32x2v vc[8]; float st[16];
#pragma unroll
        for (int j = 0; j < 8; ++j) vc[j] = bias;
        const LAS unsigned char* vp = vt + rb * 1024 + 2 * c0;
#pragma unroll
        for (int i = 0; i < 38; ++i) { const unsigned xw = *(const LAS unsigned*)(vp + i * 1024); const f32x2v x = {bf_lo(xw), bf_hi(xw)};
#pragma unroll
            for (int j = 0; j < 8; ++j) { const int k = i - j; if (k >= 0 && k < 31) vc[j] += w[k] * x; }
            if ((i & 7) == 7) asm volatile("" ::: "memory"); }
#pragma unroll
        for (int j = 0; j < 8; ++j) { const f32x2v a = vc[j]; st[j] = a.x + a.y; st[8 + j] = a.x * a.x + a.y * a.y; }
        { const float tot = xreduce<16>(st, lane); if ((lane & 3) == 0) red1[(tg * 16 + ((lane >> 2) & 15)) * 4 + cg] = tot; }
        __syncthreads();
        float q[8];
#pragma unroll
        for (int j = 0; j < 8; ++j) {
            const f32x4 a = *(const LAS f32x4*)(red1 + (tg * 16 + j) * 4), b = *(const LAS f32x4*)(red1 + (tg * 16 + 8 + j) * 4);
            const float mean = ((a.x + a.y) + (a.z + a.w)) * (1.0f / DC), ex2 = ((b.x + b.y) + (b.z + b.w)) * (1.0f / DC);
            const float rstd = 1.0f / sqrtf(fmaxf(ex2 - mean * mean, 0.f) + EPS);
            f32x2v y = (vc[j] - mean) * rstd * lg + lb; y.x *= sigm(y.x); y.y *= sigm(y.y);
            vc[j] = y; q[j] = y.x * y.x + y.y * y.y; }
        { const float tot = xreduce<8>(q, lane); if ((lane & 7) == 0) red2[(tg * 8 + ((lane >> 3) & 7)) * 4 + cg] = tot; }
        __syncthreads();
#pragma unroll
        for (int j = 0; j < 8; ++j) {
            const f32x4 a = *(const LAS f32x4*)(red2 + (tg * 8 + j) * 4);
            const float rinv = 1.0f / sqrtf(((a.x + a.y) + (a.z + a.w)) * (1.0f / DC) + EPS);
            const f32x2v y = vc[j] * rinv * og;
            *(unsigned*)(F.MIX + (size_t)(u.row0 + tb0 + j) * D + DR + c0) = pk2(y.x, y.y); }
    }
}
__device__ __forceinline__ void state_copy(Frame& F) {
    const int gt = F.bid * (NWAVES * 64) + F.tid, NGT = F.G * NWAVES * 64;
    constexpr int NC = (NB + SB) * 3 * DR, NDW = (NB + SB) * 30 * DC;
    for (int i = gt; i < NC + NDW; i += NGT) {
        if (i < NC) { const int c = i & 511, j = (i >> 9) % 3, sq = (i >> 9) / 3;
            if (sq < NB) F.out[O_CONV_P + (size_t)(sq * 3 + j) * DR + c] = bf_lo(F.XR[(size_t)(sq * SEQ + SEQ - 3 + j) * ZCOLS + c]);
            else { const int b = sq - NB; F.out[O_CONV_S + (size_t)(b * 3 + j) * DR + c] = bf_lo(F.XR[(size_t)(M_PROMPT + b * SS + SS - 3 + j) * ZCOLS + c]); }
        } else { const int i2 = i - NC, c = i2 & 511, j = (i2 >> 9) % 30, sq = (i2 >> 9) / 30;
            if (sq < NB) F.out[O_DW_P + (size_t)(sq * 30 + j) * DC + c] = bf_lo(F.V[(size_t)(sq * SEQ + SEQ - 30 + j) * ZCOLS + c]);
            else { const int b = sq - NB; F.out[O_DW_S + (size_t)(b * 30 + j) * DC + c] = bf_lo(F.V[(size_t)(M_PROMPT + b * SS + SS - 30 + j) * ZCOLS + c]); }
        }
    }
}
template <int MT, int NT, int KW  , int MODE>
__device__ __forceinline__ void rgemm_tile(Frame& F, const bf16* A, const bf16* Bt, int row0, int b0, int bhalf, int ctile) {
    constexpr int K = KW * 8, NF = MT * NT;
    const int lane = F.lane, wv = F.wave; int fr = lane & 15, fq = lane >> 4;
    asm volatile("" : "+v"(fr), "+v"(fq));
    f32x4 acc[MT][NT];
#pragma unroll
    for (int m = 0; m < MT; ++m)
#pragma unroll
        for (int n = 0; n < NT; ++n) acc[m][n] = (f32x4){0.f, 0.f, 0.f, 0.f};
    const unsigned koff = (unsigned)(wv * KW + 8 * fq);
    unsigned aoff[MT], boff[NT];
#pragma unroll
    for (int m = 0; m < MT; ++m) aoff[m] = ((unsigned)(row0 + 16 * m + fr) * (unsigned)K + koff) * 2u;
#pragma unroll
    for (int n = 0; n < NT; ++n) boff[n] = ((unsigned)(b0 + 16 * (n % (NT / 2)) + (n / (NT / 2)) * bhalf + fr) * (unsigned)K + koff) * 2u;
#pragma unroll 4
    for (int kk = 0; kk < KW; kk += 32) {
        bf16x8 a[MT], b[NT];
#pragma unroll
        for (int m = 0; m < MT; ++m) a[m] = *(const bf16x8*)((const char*)A + aoff[m] + kk * 2);
#pragma unroll
        for (int n = 0; n < NT; ++n) b[n] = *(const bf16x8*)((const char*)Bt + boff[n] + kk * 2);
#pragma unroll
        for (int m = 0; m < MT; ++m)
#pragma unroll
            for (int n = 0; n < NT; ++n) acc[m][n] = __builtin_amdgcn_mfma_f32_16x16x32_bf16(b[n], a[m], acc[m][n], 0, 0, 0);
    }
    LAS f32x4* red = (LAS f32x4*)F.lds;
#pragma unroll
    for (int m = 0; m < MT; ++m)
#pragma unroll
        for (int n = 0; n < NT; ++n) red[(wv * NF + m * NT + n) * 64 + lane] = acc[m][n];
    __syncthreads();
    const int r = F.tid >> 4, q0 = F.tid & 15;
    static_assert(MT == 2, "thread -> row mapping assumes a 32-row tile");
    const int m = r >> 4, lrow = r & 15; const size_t R = (size_t)row0 + r;
    float ss = 0.f;
#pragma unroll
    for (int i = 0; i < NT / 4; ++i) {
        const int q = q0 + 16 * i, n = q >> 2, ln = lrow + 16 * (q & 3);
        if (MODE == 0 && bhalf != 16 * (NT / 2) && n >= NT / 2) continue;
        f32x4 v = {0.f, 0.f, 0.f, 0.f}, g = {0.f, 0.f, 0.f, 0.f};
#pragma unroll
        for (int w = 0; w < 8; ++w) v += red[(w * NF + m * NT + n) * 64 + ln];
        if (MODE == 0) {
            const bool glu = bhalf != 16 * (NT / 2);
            if (glu) {
#pragma unroll
                for (int w = 0; w < 8; ++w) g += red[(w * NF + m * NT + n + NT / 2) * 64 + ln];
#pragma unroll
                for (int j = 0; j < 4; ++j) v[j] *= sigm(g[j]);
                u32x2v w2; w2.x = pk2(v[0], v[1]); w2.y = pk2(v[2], v[3]); *(u32x2v*)(F.V + R * ZCOLS + 32 * (ctile - 16) + 4 * q) = w2;
            } else {
                bf16* dst = ctile < 8 ? F.XR + R * ZCOLS + 64 * ctile : F.GG + R * ZCOLS + 64 * (ctile - 8);
                if (ctile >= 8) {
#pragma unroll
                    for (int j = 0; j < 4; ++j) v[j] = pg8::gelu_tanh(v[j]); }
                u32x2v w2; w2.x = pk2(v[0], v[1]); w2.y = pk2(v[2], v[3]); *(u32x2v*)(dst + 4 * q) = w2;
            }
        } else if (MODE == 1 || MODE == 3) {
            const int col = 16 * NT * ctile + 4 * q;
            const float* xin = MODE == 1 ? F.x_sample + (R - M_PROMPT) * D + col : F.out + R * D + col;
            const f32x4 o = *(const f32x4*)xin + v;
            *(f32x4*)(F.out + R * D + col) = o; ss += (o[0] * o[0] + o[1] * o[1]) + (o[2] * o[2] + o[3] * o[3]);
            if (MODE == 1) { u32x2v w2; w2.x = pk2(o[0], o[1]); w2.y = pk2(o[2], o[3]); *(u32x2v*)(F.X1B + R * D + col) = w2; }
        } else {
            const float* sp = F.SSQ1 + R * 16; const f32x4 p0 = *(const f32x4*)sp, p1 = *(const f32x4*)(sp + 4), p2 = *(const f32x4*)(sp + 8), p3 = *(const f32x4*)(sp + 12);
            const f32x4 ps = (p0 + p1) + (p2 + p3); const float rinv = 1.0f / sqrtf(((ps[0] + ps[1]) + (ps[2] + ps[3])) * (1.0f / D) + EPS);
#pragma unroll
            for (int j = 0; j < 4; ++j) { const float t = fmaxf(v[j] * rinv, 0.f); v[j] = t * t; }
            u32x2v w2; w2.x = pk2(v[0], v[1]); w2.y = pk2(v[2], v[3]); *(u32x2v*)(F.U + R * FF + 16 * NT * ctile + 4 * q) = w2;
        }
    }
    if (MODE == 1 || MODE == 3) {
        ss += __shfl_xor(ss, 1); ss += __shfl_xor(ss, 2); ss += __shfl_xor(ss, 4); ss += __shfl_xor(ss, 8);
        if (q0 == 0) (MODE == 1 ? F.SSQ1 : F.SSQ2)[R * 16 + ctile] = ss;
    }
    __syncthreads();
}
__device__ __forceinline__ void final_norm(Frame& F) {
    const int gw = F.bid * NWAVES + F.wave, NGW = F.G * NWAVES, lane = F.lane;
    for (int m = gw; m < M_MAIN; m += NGW) {
        const float p = lane < 16 ? F.SSQ2[(size_t)m * 16 + lane] : 0.f;
        const float rinv = 1.0f / sqrtf(wave_sum(p) * (1.0f / D) + EPS);
        GAS f32x4* xr = (GAS f32x4*)(F.out + (size_t)m * D) + lane; const GAS f32x4* gr = (const GAS f32x4*)F.norm_final + lane;
        f32x4 v[4];
#pragma unroll
        for (int j = 0; j < 4; ++j) v[j] = xr[64 * j];
#pragma unroll
        for (int j = 0; j < 4; ++j) xr[64 * j] = v[j] * rinv * gr[64 * j];
    }
}
struct Args { const float* in[26]; float* out; unsigned char* ws; int ph_lo, ph_hi; };
__global__ void __launch_bounds__(NWAVES * 64, 2) hymba_fwd(Args args) {
    __shared__ __attribute__((aligned(16))) unsigned char lds_raw[LDS_BYTES];
    Frame F;
    F.lds = (LAS unsigned char*)lds_raw;
    F.tid = threadIdx.x; F.lane = F.tid & 63; F.wave = __builtin_amdgcn_readfirstlane(F.tid >> 6); F.G = gridDim.x; F.bid = blockIdx.x;
    unsigned char* ws = args.ws;
    F.x_prompt = args.in[0]; F.x_sample = args.in[1]; F.st_conv = args.in[2]; F.st_h = args.in[3]; F.st_dw = args.in[4]; F.meta = args.in[5]; F.norm_mix = args.in[6]; F.w_in = args.in[7];
    F.cw = args.in[8]; F.cb = args.in[9]; F.wgr = args.in[10]; F.bgr = args.in[11]; F.wgi = args.in[12]; F.bgi = args.in[13]; F.lam = args.in[14]; F.dww = args.in[15]; F.dwb = args.in[16];
    F.lng = args.in[17]; F.lnb = args.in[18]; F.onr = args.in[19]; F.onc = args.in[20]; F.w_out = args.in[21]; F.norm_mlp = args.in[22]; F.w_up = args.in[23]; F.w_down = args.in[24]; F.norm_final = args.in[25];
    F.out = args.out;
    F.W1t = (bf16*)(ws + WS_W1); F.Wot = (bf16*)(ws + WS_WO); F.Wupt = (bf16*)(ws + WS_WUP); F.Wdt = (bf16*)(ws + WS_WDN); F.Wg = (bf16*)(ws + WS_WG); F.LU = (float*)(ws + WS_LU);
    F.AGG = (float*)(ws + WS_AGG); F.SSQ1 = (float*)(ws + WS_SSQ1); F.SSQ2 = (float*)(ws + WS_SSQ2); F.X1B = (bf16*)(ws + WS_X1B);
    F.HN = (bf16*)(ws + WS_HN); F.XR = (bf16*)(ws + WS_XR); F.GG = (bf16*)(ws + WS_GG); F.V = (bf16*)(ws + WS_V); F.MIX = (bf16*)(ws + WS_MIX); F.U = (bf16*)(ws + WS_U);
    volatile LAS unsigned* MISC = (volatile LAS unsigned*)(F.lds + MISC_OFF);
    if (F.tid < 64) MISC[F.tid] = 0u;
    __syncthreads();
    XcdBarrier bar = xcd_barrier_post((unsigned*)(ws + WS_CTL) + CW_BAR, MISC + 8);
    const int lo = args.ph_lo, hi = args.ph_hi;
#ifndef PHMASK
#define PHMASK 0xFF
#endif
#define IN(k) (((PHMASK >> (k)) & 1) && lo <= (k) && (k) < hi)
#define SEAM(k) do { if (IN(k) && IN((k) + 1)) xcd_barrier(bar); } while (0)
    if (IN(0)) { p0_prologue(F); } SEAM(0);
    if (IN(1)) { pg8::Gemm g{F.HN, F.W1t, M_PROMPT, DIN, D}; pg8::StaticOrder S; S.init(M_PROMPT, DIN, F.G, F.bid); pg8::EpiZ E{F.XR, F.GG, F.V};
        pg8::gemm_phase<pg8::EpiZ, pg8::StaticOrder, true, true>(F.lds, g, S, E);
#pragma unroll 1
        for (int t = F.bid; t < 17 * 32; t += F.G) { const int rt = t >> 5, ct = t & 31; int b0, bhalf = 32;
            if (ct < 16) b0 = 64 * ct; else { const int vt = ct - 16; b0 = 1024 + 256 * (vt >> 2) + 32 * (vt & 3); bhalf = 128; }
            rgemm_tile<2, 4, D / 8, 0>(F, F.HN, F.W1t, M_PROMPT + 32 * rt, b0, bhalf, ct); }
    } SEAM(1);
    if (IN(2)) {
#ifndef NO_CONV
        for (int uu = F.bid; uu < 264; uu += F.G) conv_unit(F, uu);
#endif
#ifndef NO_RNNA
        for (int uu = F.G - 1 - F.bid; uu < 265; uu += F.G) rnn_unit<false>(F, uu);
#endif
        state_copy(F); } SEAM(2);
    if (IN(3)) { for (int uu = F.bid; uu < 264; uu += F.G) rnn_unit<true>(F, uu); } SEAM(3);
    if (IN(4)) { pg8::Gemm g{F.MIX, F.Wot, M_PROMPT, D, D}; pg8::StaticOrder S; S.init(M_PROMPT, D, F.G, F.bid); pg8::EpiRes<true> E{F.x_prompt, F.x_sample, M_PROMPT / 256, F.out, F.X1B, F.SSQ1};
        pg8::gemm_phase<pg8::EpiRes<true>, pg8::StaticOrder, true, true>(F.lds, g, S, E);
#pragma unroll 1
        for (int t = F.bid; t < 16 * 16; t += F.G) rgemm_tile<2, 4, D / 8, 1>(F, F.MIX, F.Wot, M_PROMPT + 32 * (t >> 4), 64 * (t & 15), 32, t & 15);
    } SEAM(4);
    if (IN(5)) { pg8::Gemm g{F.X1B, F.Wupt, M_PROMPT, FF, D}; pg8::StaticOrder S; S.init(M_PROMPT, FF, F.G, F.bid); pg8::EpiU E{F.SSQ1, F.U, FF};
        pg8::gemm_phase<pg8::EpiU, pg8::StaticOrder, true, true>(F.lds, g, S, E);
#pragma unroll 1
        for (int t = F.bid; t < 16 * 32; t += F.G) rgemm_tile<2, 8, D / 8, 2>(F, F.X1B, F.Wupt, M_PROMPT + 32 * (t >> 5), 128 * (t & 31), 64, t & 31);
    } SEAM(5);
    if (IN(6)) { pg8::Gemm g{F.U, F.Wdt, M_PROMPT, D, FF}; pg8::StaticOrder S; S.init(M_PROMPT, D, F.G, F.bid); pg8::EpiRes<false> E{F.out, F.out, 1 << 20, F.out, nullptr, F.SSQ2};
        pg8::gemm_phase<pg8::EpiRes<false>, pg8::StaticOrder, true, true>(F.lds, g, S, E);
#pragma unroll 1
        for (int t = F.bid; t < 16 * 16; t += F.G) rgemm_tile<2, 4, FF / 8, 3>(F, F.U, F.Wdt, M_PROMPT + 32 * (t >> 4), 64 * (t & 15), 32, t & 15);
    } SEAM(6);
    if (IN(7)) final_norm(F);
#undef IN
#undef SEAM
}
extern "C" void kernel_launch(void* const* d_in, const int* in_sizes, int n_in, void* d_out, int out_size, void* d_ws, size_t ws_size, hipStream_t stream) {
    static int grid = 0;
    if (grid == 0) {
        if (n_in != 26 || out_size != (int)O_END || ws_size < WS_END) { fprintf(stderr, "kernel_launch: unexpected shapes (n_in %d, out %d, ws %zu)\n", n_in, out_size, ws_size); grid = -1; return; }
        int dev = 0, cus = 0, per_cu = 0;
        if (hipGetDevice(&dev) != hipSuccess || hipDeviceGetAttribute(&cus, hipDeviceAttributeMultiprocessorCount, dev) != hipSuccess) { grid = -1; return; }
        if (hipOccupancyMaxActiveBlocksPerMultiprocessor(&per_cu, (const void*)hymba_fwd, NWAVES * 64, 0) != hipSuccess || per_cu < 1) { fprintf(stderr, "kernel_launch: occupancy query says %d blocks per CU\n", per_cu); (void)hipGetLastError(); grid = -1; return; }
        grid = cus;
    }
    if (grid < 0) return;
    if (hipMemsetAsync((char*)d_ws + WS_CTL, 0, CTL_ZERO_BYTES, stream) != hipSuccess) return;
    Args a{};
    for (int i = 0; i < 26; ++i) a.in[i] = (const float*)d_in[i];
    a.out = (float*)d_out; a.ws = (unsigned char*)d_ws; a.ph_lo = 0; a.ph_hi = 8;
    hipLaunchKernelGGL(hymba_fwd, dim3(grid), dim3(NWAVES * 64), 0, stream, a);
}
```

```cpp
#include <hip/hip_runtime.h>
#include <cstdio>
#include <cstdint>
#include <cmath>
namespace pg8 {
#define PG8_LAS __attribute__((address_space(3)))
typedef unsigned short bf16_t;
typedef short bf16x8 __attribute__((ext_vector_type(8)));
typedef float f32x4 __attribute__((ext_vector_type(4)));
typedef unsigned u32x4 __attribute__((ext_vector_type(4)));
constexpr int BM = 256, BK = 64, HALF = 128, HTB = HALF * BK * 2  , STAGE_BYTES = 8 * HTB, NXCD = 8, WGM = 8;

__host__ __device__ __forceinline__ int lds_byte(int r, int c) { const int st = (r >> 4) * 2 + (c >> 5), rr = r & 15, cc = c & 31, ob = rr * 64 + cc * 2; return st * 1024 + (ob ^ (((ob >> 9) & 1) << 5)); }
__host__ __device__ __forceinline__ void stage_rc(int b, int& R, int& C) { const int st = b / 1024, sb = b % 1024, swz = sb ^ (((sb >> 9) & 1) << 5); R = (st >> 1) * 16 + swz / 64; C = (st & 1) * 32 + (swz % 64) / 2; }
__host__ __device__ __forceinline__ int perm32(int rho) { const int n = rho >> 4, i = rho & 15; return 8 * (i >> 2) + 4 * n + (i & 3); }

struct Unit { int pm, pn; };
struct Gemm { const bf16_t* A; const bf16_t* Bt; int M, N, K; };

struct StaticOrder {
    int nM, nN, nwg, G, c;
    __host__ __device__ void init(int M, int N, int G_, int c_) { nM = M / BM; nN = N / BM; nwg = nM * nN; G = G_; c = c_; }
    __host__ __device__ bool next(int i, Unit& u) const {
        const long L = (long)i * G + c; if (L >= nwg) return false;
        int wgid = (int)L; { const int q = nwg / NXCD, r = nwg % NXCD, xcd = wgid % NXCD, off = wgid / NXCD; wgid = (xcd < r ? xcd * (q + 1) : r * (q + 1) + (xcd - r) * q) + off; }
        const int nig = WGM * nN, gid = wgid / nig, fm = gid * WGM, gsz = (nM - fm) < WGM ? (nM - fm) : WGM;
        u.pm = fm + ((wgid % nig) % gsz); u.pn = (wgid % nig) / gsz; return true;
    }
    __device__ __forceinline__ void a_ready(const Unit&) const {}
    __device__ __forceinline__ void done(const Unit&) const {}
};

__device__ __forceinline__ unsigned cvt_pk_bf16(float lo, float hi) { unsigned r; asm volatile("v_cvt_pk_bf16_f32 %0, %1, %2" : "=v"(r) : "v"(lo), "v"(hi)); return r; }
typedef float f32x2 __attribute__((ext_vector_type(2)));
__device__ __forceinline__ float fast_sigmoid(float x) { return __builtin_amdgcn_rcpf(1.0f + __builtin_amdgcn_exp2f(-1.4426950408889634f * x)); }
__device__ __forceinline__ float gelu_tanh(float x) {
    const float t = x * (1.0f + 0.044715f * x * x);
    return x * __builtin_amdgcn_rcpf(1.0f + __builtin_amdgcn_exp2f(-2.3022081985f * t));
}
constexpr int ZC = 512;
struct EpiZ {
    static constexpr bool PERM = true, AFTER_DRAIN = false;
    bf16_t *XR, *GG, *V;
    __device__ __forceinline__ void operator()(const f32x4 (&acc)[2][2][4][2], const Unit& u, int wr, int wc, int fr, int fq) const {
        const int row0 = u.pm * BM + wr * 64 + fr, cw = wc * 32 + 8 * fq;
        if (u.pn < 4) {
            bf16_t* base = (u.pn < 2 ? XR : GG) + (u.pn & 1) * 256 + cw; const bool act = u.pn >= 2;
#pragma unroll
            for (int ai = 0; ai < 2; ++ai)
#pragma unroll
                for (int m = 0; m < 4; ++m) { bf16_t* rowp = base + (size_t)(row0 + ai * HALF + m * 16) * ZC;
#pragma unroll
                    for (int bj = 0; bj < 2; ++bj) { f32x4 v0 = acc[ai][bj][m][0], v1 = acc[ai][bj][m][1];
                        if (act) {
#pragma unroll
                            for (int j = 0; j < 4; ++j) { v0[j] = gelu_tanh(v0[j]); v1[j] = gelu_tanh(v1[j]); } }
                        u32x4 w; w.x = cvt_pk_bf16(v0[0], v0[1]); w.y = cvt_pk_bf16(v0[2], v0[3]); w.z = cvt_pk_bf16(v1[0], v1[1]); w.w = cvt_pk_bf16(v1[2], v1[3]);
                        *(u32x4*)(rowp + bj * HALF) = w; } }
        } else {
            bf16_t* base = V + (u.pn - 4) * 128 + cw;
#pragma unroll
            for (int ai = 0; ai < 2; ++ai)
#pragma unroll
                for (int m = 0; m < 4; ++m) { bf16_t* rowp = base + (size_t)(row0 + ai * HALF + m * 16) * ZC;
                    f32x4 v0 = acc[ai][0][m][0], v1 = acc[ai][0][m][1]; const f32x4 g0 = acc[ai][1][m][0], g1 = acc[ai][1][m][1];
#pragma unroll
                    for (int j = 0; j < 4; ++j) { v0[j] *= fast_sigmoid(g0[j]); v1[j] *= fast_sigmoid(g1[j]); }
                    u32x4 w; w.x = cvt_pk_bf16(v0[0], v0[1]); w.y = cvt_pk_bf16(v0[2], v0[3]); w.z = cvt_pk_bf16(v1[0], v1[1]); w.w = cvt_pk_bf16(v1[2], v1[3]);
                    *(u32x4*)rowp = w; }
        }
    }
};
typedef unsigned u32x2 __attribute__((ext_vector_type(2)));
template <bool WITH_BF16> struct EpiRes {
    static constexpr bool PERM = false, AFTER_DRAIN = false;
    const float* xa; const float* xb; int pm_split;
    float* X1; bf16_t* X1B; float* SSQ;
    __device__ __forceinline__ void operator()(const f32x4 (&acc)[2][2][4][2], const Unit& u, int wr, int wc, int fr, int fq) const {
        const float* xin = (u.pm < pm_split) ? xa + (size_t)u.pm * BM * 1024 : xb + (size_t)(u.pm - pm_split) * BM * 1024;
        const int col0 = u.pn * BM + wc * 32 + 4 * fq;
#pragma unroll
        for (int ai = 0; ai < 2; ++ai)
#pragma unroll
            for (int m = 0; m < 4; ++m) { const int rl = ai * HALF + wr * 64 + m * 16 + fr; const size_t R = (size_t)u.pm * BM + rl; float s = 0.f;
#pragma unroll
                for (int bj = 0; bj < 2; ++bj)
#pragma unroll
                    for (int n = 0; n < 2; ++n) { const int off = col0 + bj * HALF + n * 16; const f32x4 xv = *(const f32x4*)(xin + (size_t)rl * 1024 + off); const f32x4 o = xv + acc[ai][bj][m][n];
                        *(f32x4*)(X1 + R * 1024 + off) = o; s += (o[0] * o[0] + o[1] * o[1]) + (o[2] * o[2] + o[3] * o[3]);
                        if (WITH_BF16) { u32x2 w; w.x = cvt_pk_bf16(o[0], o[1]); w.y = cvt_pk_bf16(o[2], o[3]); *(u32x2*)(X1B + R * 1024 + off) = w; } }
                s += __shfl_xor(s, 16); s += __shfl_xor(s, 32);
                if (fq == 0) SSQ[R * 16 + u.pn * 4 + wc] = s;
                asm volatile("" ::: "memory"); }
    }
};
struct EpiU {
    static constexpr bool PERM = true, AFTER_DRAIN = false;
    const float* SSQ; bf16_t* U; int ldc;
    __device__ __forceinline__ void operator()(const f32x4 (&acc)[2][2][4][2], const Unit& u, int wr, int wc, int fr, int fq) const {
        const int row0 = u.pm * BM + wr * 64 + fr, col0 = u.pn * BM + wc * 32 + 8 * fq;
#pragma unroll
        for (int ai = 0; ai < 2; ++ai)
#pragma unroll
            for (int m = 0; m < 4; ++m) { const size_t R = (size_t)(row0 + ai * HALF + m * 16);
                const f32x4 p0 = *(const f32x4*)(SSQ + R * 16), p1 = *(const f32x4*)(SSQ + R * 16 + 4), p2 = *(const f32x4*)(SSQ + R * 16 + 8), p3 = *(const f32x4*)(SSQ + R * 16 + 12);
                const f32x4 ps = (p0 + p1) + (p2 + p3); const float rinv = __builtin_amdgcn_rsqf(((ps[0] + ps[1]) + (ps[2] + ps[3])) * (1.0f / 1024.0f) + 1e-6f);
                bf16_t* rowp = U + R * ldc + col0;
#pragma unroll
                for (int bj = 0; bj < 2; ++bj) { f32x4 v0 = acc[ai][bj][m][0] * rinv, v1 = acc[ai][bj][m][1] * rinv;
#pragma unroll
                    for (int j = 0; j < 4; ++j) { const float a = fmaxf(v0[j], 0.f), b = fmaxf(v1[j], 0.f); v0[j] = a * a; v1[j] = b * b; }
                    u32x4 w; w.x = cvt_pk_bf16(v0[0], v0[1]); w.y = cvt_pk_bf16(v0[2], v0[3]); w.z = cvt_pk_bf16(v1[0], v1[1]); w.w = cvt_pk_bf16(v1[2], v1[3]);
                    *(u32x4*)(rowp + bj * HALF) = w; } }
    }
};
template <class Epi, class Sched, bool ALIGN_EPI = false, bool SP2 = false>
__device__ __forceinline__ void gemm_phase(PG8_LAS unsigned char* lds, const Gemm g, const Sched& S, const Epi& E) {
    int tid_ = threadIdx.x; asm volatile("" : "+v"(tid_));
    const int tid = tid_, wid = __builtin_amdgcn_readfirstlane(tid >> 6), lane = tid & 63, wr = wid >> 2, wc = wid & 3, fr = lane & 15, fq = lane >> 4;
    const int K = g.K, nt = K / BK;
    unsigned voffA[2], voffB[2];
#pragma unroll
    for (int i = 0; i < 2; ++i) { int R, C; stage_rc(tid * 16 + i * 8192, R, C); const int Rb = Epi::PERM ? ((R & ~31) + perm32(R & 31)) : R;
        voffA[i] = (unsigned)(R * K + C) * 2u; voffB[i] = (unsigned)(Rb * K + C) * 2u; }
    const size_t kstep = (size_t)(BK * 2);
    const size_t hstep = (size_t)HALF * K * 2;
    const size_t tstep = 2 * hstep;
    const unsigned ldsw = (unsigned)wid * 1024u;
    const int aoff = lds_byte(wr * 64 + fr, fq * 8), boff = lds_byte(wc * 32 + fr, fq * 8);
#define PG8_SA(b, h) (((b) * 2 + (h)) * HTB)
#define PG8_SB(b, h) ((4 + (b) * 2 + (h)) * HTB)
#define PG8_STAGE(bufoff, gbase, voff) do { _Pragma("unroll") for (int _i = 0; _i < 2; ++_i) \
        __builtin_amdgcn_global_load_lds((const unsigned*)((const char*)(gbase) + (voff)[_i]), (PG8_LAS unsigned*)(lds + (bufoff) + ldsw + _i * 8192), 16, 0, 0); } while (0)
#define PG8_LDA(dst, b, h) do { _Pragma("unroll") for (int m = 0; m < 4; ++m) _Pragma("unroll") for (int k = 0; k < 2; ++k) dst[m][k] = *(const PG8_LAS bf16x8*)(lds + PG8_SA(b, h) + aoff + m * 2048 + k * 1024); } while (0)
#define PG8_LDB(dst, b, h) do { _Pragma("unroll") for (int n = 0; n < 2; ++n) _Pragma("unroll") for (int k = 0; k < 2; ++k) dst[n][k] = *(const PG8_LAS bf16x8*)(lds + PG8_SB(b, h) + boff + n * 2048 + k * 1024); } while (0)
#define PG8_MMA(ai, bj, At, Bt) do { __builtin_amdgcn_s_setprio(1); _Pragma("unroll") for (int m = 0; m < 4; ++m) _Pragma("unroll") for (int n = 0; n < 2; ++n) _Pragma("unroll") for (int k = 0; k < 2; ++k) \
        acc[ai][bj][m][n] = __builtin_amdgcn_mfma_f32_16x16x32_bf16(Bt[n][k], At[m][k], acc[ai][bj][m][n], 0, 0, 0); __builtin_amdgcn_s_setprio(0); } while (0)
#define PG8_WAIT_V(n) asm volatile("s_waitcnt vmcnt(" #n ")" ::: "memory")
#define PG8_WAIT_L(n) asm volatile("s_waitcnt lgkmcnt(" #n ")" ::: "memory")
#define PG8_BAR __builtin_amdgcn_s_barrier()
#define PG8_SCHED __builtin_amdgcn_sched_barrier(0)
    Unit cur, nxt; int ui = 0;
    if (!S.next(0, cur)) return;
    f32x4 acc[2][2][4][2];
#pragma unroll
    for (int a = 0; a < 2; ++a)
#pragma unroll
        for (int b = 0; b < 2; ++b)
#pragma unroll
            for (int m = 0; m < 4; ++m)
#pragma unroll
                for (int n = 0; n < 2; ++n) acc[a][b][m][n] = (f32x4){0.f, 0.f, 0.f, 0.f};
    bf16x8 At[4][2], B0[2][2], B1[2][2];
    const char* cA = (const char*)g.A + (size_t)cur.pm * tstep; const char* cB = (const char*)g.Bt + (size_t)cur.pn * tstep;
    S.a_ready(cur);
    if constexpr (SP2) {
        PG8_STAGE(PG8_SB(0, 0), cB, voffB); PG8_STAGE(PG8_SB(0, 1), cB + hstep, voffB); PG8_STAGE(PG8_SA(0, 0), cA, voffA); PG8_STAGE(PG8_SA(0, 1), cA + hstep, voffA);
        if (wr == 1) PG8_BAR;
        PG8_WAIT_V(2); PG8_BAR;
        PG8_STAGE(PG8_SB(1, 0), cB + kstep, voffB); PG8_STAGE(PG8_SA(1, 0), cA + kstep, voffA); PG8_STAGE(PG8_SB(1, 1), cB + hstep + kstep, voffB);
        PG8_WAIT_V(6); PG8_BAR;
    } else {
        PG8_STAGE(PG8_SB(0, 0), cB, voffB); PG8_STAGE(PG8_SA(0, 0), cA, voffA); PG8_STAGE(PG8_SB(0, 1), cB + hstep, voffB); PG8_STAGE(PG8_SA(0, 1), cA + hstep, voffA);
        if (wr == 1) PG8_BAR;
        PG8_WAIT_V(4); PG8_BAR;
        PG8_STAGE(PG8_SB(1, 0), cB + kstep, voffB); PG8_STAGE(PG8_SA(1, 0), cA + kstep, voffA); PG8_STAGE(PG8_SB(1, 1), cB + hstep + kstep, voffB);
        PG8_WAIT_V(6); PG8_BAR;
    }
    for (;;) {
        const bool has_next = S.next(ui + 1, nxt);
        const char* nA = has_next ? (const char*)g.A + (size_t)nxt.pm * tstep : cA; const char* nB = has_next ? (const char*)g.Bt + (size_t)nxt.pn * tstep : cB;
        for (int t = 0; t < nt; t += 2) {
            const bool last = (t == nt - 2);
            const char* a1 = cA + (size_t)(t + 1) * kstep;
            const char* a2 = last ? nA : cA + (size_t)(t + 2) * kstep; const char* b2 = last ? nB : cB + (size_t)(t + 2) * kstep;
            const char* a3 = a2 + kstep; const char* b3 = b2 + kstep;
            if (last && has_next) S.a_ready(nxt);
            if constexpr (SP2) {
            PG8_LDB(B0, 0, 0); PG8_LDB(B1, 0, 1); PG8_SCHED; PG8_LDA(At, 0, 0); PG8_STAGE(PG8_SA(1, 1), a1 + hstep, voffA);
            PG8_WAIT_V(8); PG8_WAIT_L(0); PG8_BAR; PG8_MMA(0, 0, At, B0); PG8_MMA(0, 1, At, B1); PG8_BAR; PG8_SCHED;
            PG8_LDA(At, 0, 1); PG8_STAGE(PG8_SB(0, 0), b2, voffB); PG8_STAGE(PG8_SB(0, 1), b2 + hstep, voffB); PG8_STAGE(PG8_SA(0, 0), a2, voffA);
            PG8_WAIT_V(8); PG8_WAIT_L(0); PG8_BAR; PG8_MMA(1, 0, At, B0); PG8_MMA(1, 1, At, B1); PG8_BAR; PG8_SCHED;
            PG8_LDB(B0, 1, 0); PG8_LDB(B1, 1, 1); PG8_SCHED; PG8_LDA(At, 1, 0); PG8_STAGE(PG8_SA(0, 1), a2 + hstep, voffA);
            PG8_WAIT_V(8); PG8_WAIT_L(0); PG8_BAR; PG8_MMA(0, 0, At, B0); PG8_MMA(0, 1, At, B1); PG8_BAR; PG8_SCHED;
            PG8_LDA(At, 1, 1); PG8_STAGE(PG8_SB(1, 0), b3, voffB); PG8_STAGE(PG8_SB(1, 1), b3 + hstep, voffB); PG8_STAGE(PG8_SA(1, 0), a3, voffA);
            PG8_WAIT_V(8); PG8_WAIT_L(0); PG8_BAR; PG8_MMA(1, 0, At, B0); PG8_MMA(1, 1, At, B1); PG8_BAR; PG8_SCHED;
            } else {
            PG8_LDB(B0, 0, 0); PG8_SCHED; PG8_LDA(At, 0, 0); PG8_STAGE(PG8_SA(1, 1), a1 + hstep, voffA);
            PG8_WAIT_L(8); PG8_BAR; PG8_WAIT_L(0); PG8_MMA(0, 0, At, B0); PG8_BAR; PG8_SCHED;
            PG8_LDB(B1, 0, 1); PG8_STAGE(PG8_SB(0, 0), b2, voffB);
            PG8_BAR; PG8_WAIT_L(0); PG8_MMA(0, 1, At, B1); PG8_BAR;
            PG8_LDA(At, 0, 1); PG8_STAGE(PG8_SA(0, 0), a2, voffA);
            PG8_BAR; PG8_WAIT_L(0); PG8_MMA(1, 0, At, B0); PG8_BAR; PG8_SCHED;
            PG8_STAGE(PG8_SB(0, 1), b2 + hstep, voffB);
            PG8_WAIT_V(6); PG8_BAR; PG8_MMA(1, 1, At, B1); PG8_BAR;
            PG8_LDB(B0, 1, 0); PG8_SCHED; PG8_LDA(At, 1, 0); PG8_STAGE(PG8_SA(0, 1), a2 + hstep, voffA);
            PG8_WAIT_L(8); PG8_BAR; PG8_WAIT_L(0); PG8_MMA(0, 0, At, B0); PG8_BAR; PG8_SCHED;
            PG8_LDB(B1, 1, 1); PG8_STAGE(PG8_SB(1, 0), b3, voffB);
            PG8_BAR; PG8_WAIT_L(0); PG8_MMA(0, 1, At, B1); PG8_BAR;
            PG8_LDA(At, 1, 1); PG8_STAGE(PG8_SA(1, 0), a3, voffA);
            PG8_BAR; PG8_WAIT_L(0); PG8_MMA(1, 0, At, B0); PG8_BAR; PG8_SCHED;
            PG8_STAGE(PG8_SB(1, 1), b3 + hstep, voffB);
            PG8_WAIT_V(6); PG8_BAR; PG8_MMA(1, 1, At, B1); PG8_BAR;
            }
        }
        if constexpr (ALIGN_EPI) { if (wr == 0) PG8_BAR; }
        if constexpr (!Epi::AFTER_DRAIN) { E(acc, cur, wr, wc, fr, fq); S.done(cur); }
        if (!has_next) break;
#pragma unroll
        for (int a = 0; a < 2; ++a)
#pragma unroll
            for (int b = 0; b < 2; ++b)
#pragma unroll
                for (int m = 0; m < 4; ++m)
#pragma unroll
                    for (int n = 0; n < 2; ++n) acc[a][b][m][n] = (f32x4){0.f, 0.f, 0.f, 0.f};
        cur = nxt; cA = nA; cB = nB; ++ui;
        if constexpr (ALIGN_EPI) { if (wr == 1) PG8_BAR; }
    }
    PG8_WAIT_V(0);
    if constexpr (!ALIGN_EPI) { if (wr == 0) PG8_BAR; }
    PG8_BAR;
    if constexpr (Epi::AFTER_DRAIN) { E.fused(acc, cur, wr, wc, fr, fq, lds, wid, lane); S.done(cur); }
#undef PG8_SA
#undef PG8_SB
#undef PG8_STAGE
#undef PG8_LDA
#undef PG8_LDB
#undef PG8_MMA
#undef PG8_WAIT_V
#undef PG8_WAIT_L
#undef PG8_BAR
#undef PG8_SCHED
}
}
#define GAS __attribute__((address_space(1)))
#define LAS __attribute__((address_space(3)))
typedef unsigned short bf16;
typedef unsigned v4u __attribute__((ext_vector_type(4)));
typedef float f32x4 __attribute__((ext_vector_type(4)));
typedef short bf16x8 __attribute__((ext_vector_type(8)));
typedef GAS unsigned gu32;
typedef GAS unsigned long long gu64;
#define RLX_AGENT __ATOMIC_RELAXED, __HIP_MEMORY_SCOPE_AGENT
#define LDS_WAIT() asm volatile("s_waitcnt lgkmcnt(0)" ::: "memory")
#define VM_WAIT() asm volatile("s_waitcnt vmcnt(0)" ::: "memory")
__device__ __forceinline__ unsigned long long rt() { return __builtin_amdgcn_s_memrealtime(); }
__device__ __forceinline__ unsigned f2bf(float f) { unsigned u = __builtin_bit_cast(unsigned, f); return (u + 0x7fffu + ((u >> 16) & 1u)) >> 16; }
__device__ __forceinline__ unsigned pk2(float lo, float hi) { return f2bf(lo) | (f2bf(hi) << 16); }
#define XB_TMO      128
#define XB_XCNT(j)  (256  + 64 * (j))
#define XB_XSUB(j)  (1280 + 64 * (j))
#define XB_XGEN(j)  (2304 + 64 * (j))
#define XB_TOP      3328
#define XB_TOPGEN   3392
#define XCD_BAR_WORDS 3456
#define XB_SPIN_CAP (1u << 18)

__device__ __forceinline__ unsigned xb_ld(unsigned* p)              { return __hip_atomic_load(p, __ATOMIC_RELAXED, __HIP_MEMORY_SCOPE_AGENT); }
__device__ __forceinline__ unsigned xb_add(unsigned* p, unsigned v) { return __hip_atomic_fetch_add(p, v, __ATOMIC_RELAXED, __HIP_MEMORY_SCOPE_AGENT); }
__device__ __forceinline__ unsigned xb_xcc_id() { return (unsigned)__builtin_amdgcn_s_getreg((3 << 11) | 20) & 0xFu; }
#define XB_SPIN(cond, bar) do { unsigned _sp = 0; while (cond) { __builtin_amdgcn_s_sleep(1); \
    if ((++_sp & 255u) == 0u) { if (xb_ld(&(bar)[XB_TMO])) break; if (_sp > XB_SPIN_CAP) { atomicAdd(&(bar)[XB_TMO], 1u); break; } } } } while (0)

struct XcdBarrier {
    unsigned* bar; unsigned x;
    volatile LAS unsigned* st;
};

__device__ __forceinline__ XcdBarrier xcd_barrier_post(unsigned* bar, volatile LAS unsigned* st) {
    XcdBarrier b; b.bar = bar; b.x = xb_xcc_id(); b.st = st;
    if (threadIdx.x == 0) (void)xb_add(&bar[XB_XCNT(b.x)], 1u);
    return b;
}
__device__ __forceinline__ void xcd_barrier_complete(unsigned* bar, unsigned x, unsigned& nloc, unsigned& nx) {
    const unsigned G = gridDim.x * gridDim.y * gridDim.z;
    unsigned sum, cnt, mine, sp = 0u;
    for (;;) {
        sum = 0u; cnt = 0u; mine = 0u;
#pragma unroll
        for (unsigned j = 0; j < 16; ++j) { const unsigned c = xb_ld(&bar[XB_XCNT(j)]); sum += c; cnt += (c > 0u) ? 1u : 0u; mine = (j == x) ? c : mine; }
        if (sum == G) break;
        __builtin_amdgcn_s_sleep(1);
        if ((++sp & 255u) == 0u) { if (xb_ld(&bar[XB_TMO])) break; if (sp > XB_SPIN_CAP) { atomicAdd(&bar[XB_TMO], 1u); break; } }
    }
    nloc = mine > 0u ? mine : 1u; nx = cnt > 0u ? cnt : 1u;
}

__device__ __forceinline__ void xcd_barrier(const XcdBarrier& b) {
    asm volatile("s_waitcnt vmcnt(0)" ::: "memory");
    __syncthreads();
    if (threadIdx.x == 0) {
        unsigned* bar = b.bar;
        __builtin_amdgcn_s_waitcnt(0);
        unsigned nloc = b.st[0], nx = b.st[1];
        if (nloc == 0u) { xcd_barrier_complete(bar, b.x, nloc, nx); b.st[0] = nloc; b.st[1] = nx; }
        const unsigned old = xb_add(&bar[XB_XSUB(b.x)], 1u);
        const unsigned gen = old / nloc;
        if (old + 1u == (gen + 1u) * nloc) {
            __builtin_amdgcn_fence(__ATOMIC_RELEASE, "agent");
            asm volatile("s_waitcnt vmcnt(0)" ::: "memory");
            const unsigned og = xb_add(&bar[XB_TOP], 1u);
            const unsigned tg = og / nx;
            if (og + 1u == (tg + 1u) * nx) xb_add(&bar[XB_TOPGEN], 1u);
            else XB_SPIN(xb_ld(&bar[XB_TOPGEN]) == tg, bar);
            __builtin_amdgcn_fence(__ATOMIC_ACQUIRE, "agent");
            xb_add(&bar[XB_XGEN(b.x)], 1u);
            asm volatile("s_waitcnt vmcnt(0)" ::: "memory");
        } else {
            XB_SPIN(xb_ld(&bar[XB_XGEN(b.x)]) == gen, bar);
            __builtin_amdgcn_fence(__ATOMIC_ACQUIRE, "agent");
            asm volatile("s_waitcnt vmcnt(0)" ::: "memory");
        }
    }
    __syncthreads();
}
constexpr int NWAVES = 8;
constexpr int D = 1024, DIN = 2048, DR = 512, DC = 512, FF = 4096, NH = 8, HD = 64;
constexpr int NB = 4, SEQ = 4096, NMETA = 16, SB = 8, SS = 64;
constexpr int M_PROMPT = NB * SEQ;
constexpr int M_SAMPLE = SB * SS;
constexpr int M_MAIN = M_PROMPT + M_SAMPLE;
constexpr int ROW_META = M_MAIN;
constexpr int M_Z = 67 * 256;
constexpr float EPS = 1e-6f;
constexpr int ZCOLS = 512;
constexpr size_t O_Y = 0;
constexpr size_t O_CONV_P = (size_t)M_MAIN * D;
constexpr size_t O_H_P = O_CONV_P + NB * 3 * DR;
constexpr size_t O_DW_P = O_H_P + NB * DR;
constexpr size_t O_CONV_S = O_DW_P + NB * 30 * DC;
constexpr size_t O_H_S = O_CONV_S + SB * 3 * DR;
constexpr size_t O_DW_S = O_H_S + SB * DR;
constexpr size_t O_END = O_DW_S + SB * 30 * DC;
static_assert(O_END == 17510400, "d_out size");
constexpr size_t MiB = 1u << 20;
constexpr size_t WS_CTL = 0, CTL_ZERO_BYTES = 64 * 1024;
constexpr size_t WS_W1 = 2 * MiB, WS_WO = 6 * MiB, WS_WUP = 8 * MiB, WS_WDN = 16 * MiB;
constexpr size_t WS_WG = 24 * MiB;
constexpr size_t WS_LU = WS_WG + 256 * 1024;
constexpr size_t WS_AGG = 25 * MiB;
constexpr size_t WS_SSQ1 = 27 * MiB, WS_SSQ2 = 29 * MiB;
constexpr size_t WS_X1B = 32 * MiB;
constexpr size_t WS_HN = 66 * MiB;
constexpr size_t WS_XR = 100 * MiB, WS_GG = 117 * MiB, WS_V = 134 * MiB;
constexpr size_t WS_MIX = 151 * MiB;
constexpr size_t WS_U = 66 * MiB;
constexpr size_t WS_PL = 198 * MiB;
constexpr size_t WS_END = 232 * MiB;
static_assert(WS_AGG + 265 * 512 * 8 <= WS_SSQ1 && WS_SSQ1 + (size_t)M_MAIN * 64 <= WS_SSQ2 && WS_SSQ2 + (size_t)M_MAIN * 64 <= WS_X1B, "ws map 1");
static_assert(WS_X1B + (size_t)M_MAIN * D * 2 <= WS_HN && WS_HN + (size_t)M_Z * D * 2 <= WS_XR && WS_XR + (size_t)M_Z * 512 * 2 <= WS_GG && WS_GG + (size_t)M_Z * 512 * 2 <= WS_V && WS_V + (size_t)M_Z * 512 * 2 <= WS_MIX, "ws map 2");
static_assert(WS_MIX + (size_t)M_MAIN * D * 2 <= WS_END && WS_U + (size_t)M_MAIN * FF * 2 <= WS_END, "ws map 3");
constexpr int CW_BAR = 4096;
static_assert((CW_BAR + 3456) * 4 <= (int)CTL_ZERO_BYTES, "CTL");
constexpr int RING_BYTES = 131072;
constexpr int MISC_OFF = RING_BYTES;
constexpr int LDS_BYTES = RING_BYTES + 256;

typedef unsigned u32x2v __attribute__((ext_vector_type(2)));
typedef float f32x2v __attribute__((ext_vector_type(2)));
__device__ __forceinline__ float bf_lo(unsigned u) { return __builtin_bit_cast(float, u << 16); }
__device__ __forceinline__ float bf_hi(unsigned u) { return __builtin_bit_cast(float, u & 0xffff0000u); }
__device__ __forceinline__ float sigm(float x) { return __builtin_amdgcn_rcpf(1.0f + __builtin_amdgcn_exp2f(-1.4426950408889634f * x)); }

constexpr size_t WS_CT = WS_LU + 4096;
constexpr int CT_CW = 0, CT_CB = 4 * 512, CT_BGR = 5 * 512, CT_BGI = 6 * 512, CT_DWW = 7 * 512, CT_DWB = 38 * 512, CT_LNG = 39 * 512, CT_LNB = 40 * 512, CT_ONR = 41 * 512, CT_ONC = 42 * 512, CT_NF = 43 * 512, CT_END = 45 * 512;
static_assert(WS_CT + CT_END * 4 <= WS_AGG, "constants table");
struct Frame {
    LAS unsigned char* lds;
    int tid, lane, wave, G, bid;
    unsigned char* ws; float* out;
    const float *x_prompt, *x_sample, *st_conv, *st_h, *st_dw;
#define WSP(name, type, off) __device__ __forceinline__ type* name() const { return (type*)(ws + (off)); }
    WSP(W1t, bf16, WS_W1) WSP(Wot, bf16, WS_WO) WSP(Wupt, bf16, WS_WUP) WSP(Wdt, bf16, WS_WDN) WSP(Wg, bf16, WS_WG) WSP(HN, bf16, WS_HN) WSP(XR, bf16, WS_XR) WSP(GG, bf16, WS_GG) WSP(V, bf16, WS_V)
    WSP(MIX, bf16, WS_MIX) WSP(PL, unsigned short, WS_PL) WSP(X1B, bf16, WS_X1B) WSP(U, bf16, WS_U) WSP(LU, float, WS_LU) WSP(AGG, float, WS_AGG) WSP(SSQ1, float, WS_SSQ1) WSP(SSQ2, float, WS_SSQ2)
    WSP(cw, float, WS_CT + 4 * CT_CW) WSP(cb, float, WS_CT + 4 * CT_CB) WSP(bgr, float, WS_CT + 4 * CT_BGR) WSP(bgi, float, WS_CT + 4 * CT_BGI) WSP(dww, float, WS_CT + 4 * CT_DWW) WSP(dwb, float, WS_CT + 4 * CT_DWB)
    WSP(lng, float, WS_CT + 4 * CT_LNG) WSP(lnb, float, WS_CT + 4 * CT_LNB) WSP(onr, float, WS_CT + 4 * CT_ONR) WSP(onc, float, WS_CT + 4 * CT_ONC) WSP(norm_final, float, WS_CT + 4 * CT_NF)
#undef WSP
};

__device__ __forceinline__ float wave_sum(float v) {
#pragma unroll
    for (int o = 1; o < 64; o <<= 1) v += __shfl_xor(v, o);
    return v;
}
__device__ __forceinline__ void p0_transpose_item(const float* W, int K, int N, bf16* WT, const float* gain, LAS float* scr, int k0, int n0, int dest_row0, int lane) {
#pragma unroll 8
    for (int i = 0; i < 32; ++i) { const int kk = 2 * i + (lane >> 5); float w = W[(size_t)(k0 + kk) * N + n0 + (lane & 31)]; if (gain) w *= gain[k0 + kk]; scr[kk * 33 + (lane & 31)] = w; }
    LDS_WAIT(); asm volatile("" ::: "memory");
    const int c = lane & 7;
#pragma unroll
    for (int j = 0; j < 4; ++j) { const int n = (lane >> 3) + 8 * j; const LAS float* s = scr + (8 * c) * 33 + n;
        v4u o; o.x = pk2(s[0 * 33], s[1 * 33]); o.y = pk2(s[2 * 33], s[3 * 33]); o.z = pk2(s[4 * 33], s[5 * 33]); o.w = pk2(s[6 * 33], s[7 * 33]);
        *(GAS v4u*)(WT + (size_t)(dest_row0 + n) * K + k0 + 8 * c) = o; }
    LDS_WAIT(); asm volatile("" ::: "memory");
}
__device__ __forceinline__ int w1_dest_row(int n0) {
    if (n0 < 1024) return n0;
    if (n0 < 1536) { const int q = (n0 - 1024) >> 7, tc = (n0 - 1024) & 127; return 1024 + 256 * q + tc; }
    { const int q = (n0 - 1536) >> 7, tc = (n0 - 1536) & 127; return 1024 + 256 * q + 128 + tc; }
}
template <class ArgsT> __device__ __forceinline__ void p0_prologue(Frame& F, const ArgsT& A) {
    const float *meta = A.in[5], *norm_mix = A.in[6], *w_in = A.in[7], *wgr = A.in[10], *wgi = A.in[12], *lam = A.in[14], *w_out = A.in[21], *norm_mlp = A.in[22], *w_up = A.in[23], *w_down = A.in[24];
    LAS float* scr = (LAS float*)(F.lds + F.wave * 16384);
    const int gw = F.bid * NWAVES + F.wave, NGW = F.G * NWAVES, lane = F.lane;
    constexpr int I_1 = (D / 64) * (DIN / 32), I_O = (D / 64) * (D / 32), I_U = (D / 64) * (FF / 32), I_D = (FF / 64) * (D / 32);
    constexpr int NITEMS = I_1 + I_O + I_U + I_D;
    for (int it = gw; it < NITEMS; it += NGW) {
        int r = it;
        if (r < I_1) { const int nblk = DIN / 32, kb = r / nblk, nb = r % nblk; p0_transpose_item(w_in, D, DIN, F.W1t(), nullptr, scr, 64 * kb, 32 * nb, w1_dest_row(32 * nb), lane); continue; } r -= I_1;
        if (r < I_O) { const int nblk = D / 32, kb = r / nblk, nb = r % nblk; p0_transpose_item(w_out, D, D, F.Wot(), nullptr, scr, 64 * kb, 32 * nb, 32 * nb, lane); continue; } r -= I_O;
        if (r < I_U) { const int nblk = FF / 32, kb = r / nblk, nb = r % nblk; p0_transpose_item(w_up, D, FF, F.Wupt(), norm_mlp, scr, 64 * kb, 32 * nb, 32 * nb, lane); continue; } r -= I_U;
        { const int nblk = D / 32, kb = r / nblk, nb = r % nblk; p0_transpose_item(w_down, FF, D, F.Wdt(), nullptr, scr, 64 * kb, 32 * nb, 32 * nb, lane); }
    }
    const int gt = F.bid * (NWAVES * 64) + F.tid, NGT = F.G * NWAVES * 64;
    for (int i = gt; i < 2 * NH * HD * HD; i += NGT) { const int g = i >> 15, h = (i >> 12) & 7, e = (i >> 6) & 63, d = i & 63; const float* src = g ? wgi : wgr; F.Wg()[i] = (bf16)f2bf(src[(h * 64 + d) * 64 + e]); }
    for (int i = gt; i < DR; i += NGT) F.LU()[i] = -8.0f * log1pf(expf(-lam[i]));
    { float* ct = (float*)(F.ws + WS_CT);
      for (int i = gt; i < CT_END; i += NGT) { float v;
        if (i < CT_CB) v = A.in[8][i]; else if (i < CT_BGR) v = A.in[9][i - CT_CB]; else if (i < CT_BGI) v = A.in[11][i - CT_BGR]; else if (i < CT_DWW) v = A.in[13][i - CT_BGI];
        else if (i < CT_DWB) v = A.in[15][i - CT_DWW]; else if (i < CT_LNG) v = A.in[16][i - CT_DWB]; else if (i < CT_LNB) v = A.in[17][i - CT_LNG]; else if (i < CT_ONR) v = A.in[18][i - CT_LNB];
        else if (i < CT_ONC) v = A.in[19][i - CT_ONR]; else if (i < CT_NF) v = A.in[20][i - CT_ONC]; else v = A.in[25][i - CT_NF];
        ct[i] = v; } }
    for (int m = gw; m < M_Z; m += NGW) {
        GAS unsigned long long* o8 = (GAS unsigned long long*)(F.HN() + (size_t)m * D) + lane;
        if (m >= ROW_META + NMETA) {
#pragma unroll
            for (int j = 0; j < 4; ++j) o8[64 * j] = 0ull;
            continue; }
        const float* xrow = m < M_PROMPT ? F.x_prompt + (size_t)m * D : (m < M_MAIN ? F.x_sample + (size_t)(m - M_PROMPT) * D : meta + (size_t)(m - ROW_META) * D);
        const GAS f32x4* xr = (const GAS f32x4*)xrow + lane; const GAS f32x4* gr = (const GAS f32x4*)norm_mix + lane;
        f32x4 v[4]; float s = 0.f;
#pragma unroll
        for (int j = 0; j < 4; ++j) { v[j] = xr[64 * j]; s += (v[j].x * v[j].x + v[j].y * v[j].y) + (v[j].z * v[j].z + v[j].w * v[j].w); }
        const float rinv = 1.0f / sqrtf(wave_sum(s) * (1.f / D) + EPS);
#pragma unroll
        for (int j = 0; j < 4; ++j) { const f32x4 g = gr[64 * j]; const f32x4 y = v[j] * rinv * g; o8[64 * j] = (unsigned long long)pk2(y.x, y.y) | ((unsigned long long)pk2(y.z, y.w) << 32); }
    }
}
struct SeqUnit { int kind, b, row0, t0, ntb, j; };
__device__ __forceinline__ SeqUnit seq_unit(int id) {
    SeqUnit u;
    if (id < 256) { u.kind = 0; u.b = id >> 6; u.j = id & 63; u.row0 = u.b * SEQ; u.t0 = 64 * u.j; u.ntb = 4; }
    else if (id < 264) { u.kind = 1; u.b = id - 256; u.j = 0; u.row0 = M_PROMPT + SS * u.b; u.t0 = 0; u.ntb = 4; }
    else { u.kind = 2; u.b = 0; u.j = 0; u.row0 = ROW_META; u.t0 = 0; u.ntb = 1; }
    return u;
}
__device__ __forceinline__ float dpp_shr(float v, float ident, int sh) {
    int r;
    switch (sh) {
        case 1: r = __builtin_amdgcn_update_dpp(__builtin_bit_cast(int, ident), __builtin_bit_cast(int, v), 0x111, 0xF, 0xF, false); break;
        case 2: r = __builtin_amdgcn_update_dpp(__builtin_bit_cast(int, ident), __builtin_bit_cast(int, v), 0x112, 0xF, 0xF, false); break;
        case 4: r = __builtin_amdgcn_update_dpp(__builtin_bit_cast(int, ident), __builtin_bit_cast(int, v), 0x114, 0xF, 0xF, false); break;
        default: r = __builtin_amdgcn_update_dpp(__builtin_bit_cast(int, ident), __builtin_bit_cast(int, v), 0x118, 0xF, 0xF, false); break;
    }
    return __builtin_bit_cast(float, r);
}
typedef _Float16 h16x2 __attribute__((ext_vector_type(2)));
constexpr int RNN_WL = 12544, XT_PITCH = 144, XT_ROWS = 72, CWT_OFF = XT_ROWS * XT_PITCH  , VEC_OFF = CWT_OFF + 1024;
__device__ __forceinline__ void rnn_pass1(Frame& F) {
    const int h = F.wave, lane = F.lane;
    LAS unsigned char* wl = F.lds + h * RNN_WL;
    {
        LAS float* cwt = (LAS float*)(wl + CWT_OFF); LAS float* vec = (LAS float*)(wl + VEC_OFF);
        const float* cw = F.cw();
#pragma unroll
        for (int k = 0; k < 4; ++k) cwt[k * 64 + lane] = cw[k * DR + 64 * h + lane];
        vec[lane] = F.cb()[64 * h + lane]; vec[64 + lane] = F.bgr()[64 * h + lane]; vec[128 + lane] = F.bgi()[64 * h + lane]; vec[192 + lane] = 1.4426950408889634f * F.LU()[64 * h + lane];
    }
    int fr = lane & 15, fq = lane >> 4;
    bf16x8 Wr[4][2], Wi[4][2];
#pragma unroll
    for (int eb = 0; eb < 4; ++eb)
#pragma unroll
        for (int ks = 0; ks < 2; ++ks) { const bf16* wp = F.Wg() + ((size_t)h * HD + 16 * eb + fr) * HD + 32 * ks + 8 * fq; Wr[eb][ks] = *(const bf16x8*)wp; Wi[eb][ks] = *(const bf16x8*)(wp + NH * HD * HD); }
#pragma unroll 1
    for (int uid = F.G - 1 - F.bid; uid < 265; uid += F.G) {
        const SeqUnit u = seq_unit(uid);
        asm volatile("" : "+v"(fr), "+v"(fq));
        {   v4u val[9];
#pragma unroll
            for (int i = 0; i < 9; ++i) { const int row = 8 * i + (lane >> 3), sv = u.t0 - 3 + row;
                const bool ok = (sv >= 0 && row < 3 + 16 * u.ntb) || (sv < 0 && u.kind == 0);
                const size_t grow = sv >= 0 ? (size_t)(u.row0 + sv) : (size_t)(ROW_META + NMETA + sv);
                val[i] = *(const v4u*)(F.XR() + (ok ? grow : 0) * ZCOLS + 64 * h + 8 * (lane & 7));
                if (!ok) val[i] = (v4u){0u, 0u, 0u, 0u}; }
#pragma unroll
            for (int i = 0; i < 9; ++i) *(LAS v4u*)(wl + (8 * i + (lane >> 3)) * XT_PITCH + 16 * (lane & 7)) = val[i];
            if (u.kind == 1 && lane < 24) {
                const int row = lane >> 3; const float* p = F.st_conv + (size_t)(u.b * 3 + row) * DR + 64 * h + 8 * (lane & 7); const f32x4 a = *(const f32x4*)p, b = *(const f32x4*)(p + 4);
                v4u w; w.x = pk2(a.x, a.y); w.y = pk2(a.z, a.w); w.z = pk2(b.x, b.y); w.w = pk2(b.z, b.w); *(LAS v4u*)(wl + row * XT_PITCH + 16 * (lane & 7)) = w; }
        }
        float H[4][4], Pc[4][4];
#pragma unroll
        for (int eb = 0; eb < 4; ++eb)
#pragma unroll
            for (int r = 0; r < 4; ++r) { H[eb][r] = 0.f; Pc[eb][r] = 1.f; }
        const LAS float* cwt = (const LAS float*)(wl + CWT_OFF); const LAS float* vec = (const LAS float*)(wl + VEC_OFF);
#pragma unroll 1
        for (int tb = 0; tb < u.ntb; ++tb) {
            const int s = u.t0 + 16 * tb + fr;
            u32x2v ggw[4];
#pragma unroll
            for (int eb = 0; eb < 4; ++eb) ggw[eb] = *(const u32x2v*)(F.GG() + (size_t)(u.row0 + s) * ZCOLS + 64 * h + 16 * eb + 4 * fq);
            bf16x8 Xf[2];
#pragma unroll
            for (int ks = 0; ks < 2; ++ks) {
                const int cl = 32 * ks + 8 * fq; float a8[8];
                { const f32x4 b0 = *(const LAS f32x4*)(vec + cl), b1 = *(const LAS f32x4*)(vec + cl + 4); a8[0] = b0.x; a8[1] = b0.y; a8[2] = b0.z; a8[3] = b0.w; a8[4] = b1.x; a8[5] = b1.y; a8[6] = b1.z; a8[7] = b1.w; }
#pragma unroll
                for (int k = 0; k < 4; ++k) { const v4u xw = *(const LAS v4u*)(wl + (16 * tb + fr + k) * XT_PITCH + 2 * cl); const f32x4 w0 = *(const LAS f32x4*)(cwt + k * 64 + cl), w1 = *(const LAS f32x4*)(cwt + k * 64 + cl + 4);
                    a8[0] += w0.x * bf_lo(xw.x); a8[1] += w0.y * bf_hi(xw.x); a8[2] += w0.z * bf_lo(xw.y); a8[3] += w0.w * bf_hi(xw.y); a8[4] += w1.x * bf_lo(xw.z); a8[5] += w1.y * bf_hi(xw.z); a8[6] += w1.z * bf_lo(xw.w); a8[7] += w1.w * bf_hi(xw.w); }
                v4u pk; pk.x = pk2(a8[0], a8[1]); pk.y = pk2(a8[2], a8[3]); pk.z = pk2(a8[4], a8[5]); pk.w = pk2(a8[6], a8[7]);
                Xf[ks] = __builtin_bit_cast(bf16x8, pk);
            }
#pragma unroll
            for (int eb = 0; eb < 4; ++eb) {
                f32x4 ar = {0.f, 0.f, 0.f, 0.f}, ai = {0.f, 0.f, 0.f, 0.f};
                ar = __builtin_amdgcn_mfma_f32_16x16x32_bf16(Wr[eb][0], Xf[0], ar, 0, 0, 0); ar = __builtin_amdgcn_mfma_f32_16x16x32_bf16(Wr[eb][1], Xf[1], ar, 0, 0, 0);
                ai = __builtin_amdgcn_mfma_f32_16x16x32_bf16(Wi[eb][0], Xf[0], ai, 0, 0, 0); ai = __builtin_amdgcn_mfma_f32_16x16x32_bf16(Wi[eb][1], Xf[1], ai, 0, 0, 0);
                const int cl = 16 * eb + 4 * fq;
                f32x4 xc = *(const LAS f32x4*)(vec + cl);
#pragma unroll
                for (int k = 0; k < 4; ++k) { const u32x2v xw = *(const LAS u32x2v*)(wl + (16 * tb + fr + k) * XT_PITCH + 2 * cl); const f32x4 w0 = *(const LAS f32x4*)(cwt + k * 64 + cl);
                    xc.x += w0.x * bf_lo(xw.x); xc.y += w0.y * bf_hi(xw.x); xc.z += w0.z * bf_lo(xw.y); xc.w += w0.w * bf_hi(xw.y); }
                const f32x4 br = *(const LAS f32x4*)(vec + 64 + cl), bi = *(const LAS f32x4*)(vec + 128 + cl), lu = *(const LAS f32x4*)(vec + 192 + cl);
                const float gg[4] = {bf_lo(ggw[eb].x), bf_hi(ggw[eb].x), bf_lo(ggw[eb].y), bf_hi(ggw[eb].y)};
                v4u pl;
#pragma unroll
                for (int r = 0; r < 4; ++r) {
                    const float rg = sigm(ar[r] + br[r]), ig = sigm(ai[r] + bi[r]);
                    float A = __builtin_amdgcn_exp2f(rg * lu[r]);
                    float B = sqrtf(fmaxf(1.0f - A * A, 0.f)) * ig * xc[r];
#pragma unroll
                    for (int sh = 1; sh < 16; sh <<= 1) { const float Ap = dpp_shr(A, 1.0f, sh), Bp = dpp_shr(B, 0.0f, sh); B = A * Bp + B; A = A * Ap; }
                    const float lh = A * H[eb][r] + B, pt = A * Pc[eb][r];
                    H[eb][r] = __shfl(lh, (lane & 48) | 15); Pc[eb][r] = __shfl(pt, (lane & 48) | 15);
                    pl[r] = __builtin_bit_cast(unsigned, __builtin_amdgcn_cvt_pkrtz(pt * gg[r], lh * gg[r]));
                }
                if (u.kind != 2) *(v4u*)(F.PL() + ((size_t)(u.row0 + s) * DR + 64 * h + cl) * 2) = pl;
            }
        }
        if (fr == 0) {
#pragma unroll
            for (int eb = 0; eb < 4; ++eb) { float* p = F.AGG() + ((size_t)uid * DR + 64 * h + 16 * eb + 4 * fq) * 2;
                *(f32x4*)p = (f32x4){Pc[eb][0], H[eb][0], Pc[eb][1], H[eb][1]}; *(f32x4*)(p + 4) = (f32x4){Pc[eb][2], H[eb][2], Pc[eb][3], H[eb][3]}; }
        }
    }
}
__device__ __forceinline__ void rnn_pass2(Frame& F, int uid) {
    const SeqUnit u = seq_unit(uid);
    const int h = F.wave, lane = F.lane; int fr = lane & 15, fq = lane >> 4;
    asm volatile("" : "+v"(fr), "+v"(fq));
    float Hin[4][4];
    if (u.kind == 1) {
#pragma unroll
        for (int eb = 0; eb < 4; ++eb) { const f32x4 v = *(const f32x4*)(F.st_h + (size_t)u.b * DR + 64 * h + 16 * eb + 4 * fq); Hin[eb][0] = v.x; Hin[eb][1] = v.y; Hin[eb][2] = v.z; Hin[eb][3] = v.w; }
    } else {
        const int n = u.j + 1;
#pragma unroll
        for (int eb = 0; eb < 4; ++eb) {
            f32x4 q0[4], q1[4];
#pragma unroll
            for (int i = 0; i < 4; ++i) { const int idx = 4 * fr + i; const int au = idx == 0 ? 264 : u.b * 64 + idx - 1;
                const float* p = F.AGG() + ((size_t)(idx < n ? au : 264) * DR + 64 * h + 16 * eb + 4 * fq) * 2; q0[i] = *(const f32x4*)p; q1[i] = *(const f32x4*)(p + 4); }
            float A[4] = {1.f, 1.f, 1.f, 1.f}, B[4] = {0.f, 0.f, 0.f, 0.f};
#pragma unroll
            for (int i = 0; i < 4; ++i) { const bool ok = 4 * fr + i < n;
                const float a0 = ok ? q0[i].x : 1.f, b0 = ok ? q0[i].y : 0.f, a1 = ok ? q0[i].z : 1.f, b1 = ok ? q0[i].w : 0.f, a2 = ok ? q1[i].x : 1.f, b2 = ok ? q1[i].y : 0.f, a3 = ok ? q1[i].z : 1.f, b3 = ok ? q1[i].w : 0.f;
                B[0] = a0 * B[0] + b0; A[0] *= a0; B[1] = a1 * B[1] + b1; A[1] *= a1; B[2] = a2 * B[2] + b2; A[2] *= a2; B[3] = a3 * B[3] + b3; A[3] *= a3; }
#pragma unroll
            for (int r = 0; r < 4; ++r) {
#pragma unroll
                for (int sh = 1; sh < 16; sh <<= 1) { const float Ap = dpp_shr(A[r], 1.0f, sh), Bp = dpp_shr(B[r], 0.0f, sh); B[r] = A[r] * Bp + B[r]; A[r] = A[r] * Ap; }
                Hin[eb][r] = __shfl(B[r], (lane & 48) | 15);
            }
        }
    }
    float yv[4][4][4]; LAS float* red = (LAS float*)F.lds;
#pragma unroll
    for (int tb = 0; tb < 4; ++tb) {
        const int s = u.t0 + 16 * tb + fr; float ssq = 0.f;
#pragma unroll
        for (int eb = 0; eb < 4; ++eb) { const v4u pl = *(const v4u*)(F.PL() + ((size_t)(u.row0 + s) * DR + 64 * h + 16 * eb + 4 * fq) * 2);
#pragma unroll
            for (int r = 0; r < 4; ++r) { const unsigned plw = pl[r]; const h16x2 hv = __builtin_bit_cast(h16x2, plw);     const float y = (float)hv.x * Hin[eb][r] + (float)hv.y; yv[tb][eb][r] = y; ssq += y * y; } }
        ssq += __shfl_xor(ssq, 16); ssq += __shfl_xor(ssq, 32); if (fq == 0) red[(16 * tb + fr) * 8 + h] = ssq;
    }
    __syncthreads();
#pragma unroll
    for (int tb = 0; tb < 4; ++tb) {
        const LAS f32x4* rp = (const LAS f32x4*)(red + (16 * tb + fr) * 8); const f32x4 a = rp[0], b = rp[1];
        const float rinv = 1.0f / sqrtf(((a.x + a.y) + (a.z + a.w) + (b.x + b.y) + (b.z + b.w)) * (1.0f / DR) + EPS);
        bf16* orow = F.MIX() + (size_t)(u.row0 + u.t0 + 16 * tb + fr) * D + 64 * h + 4 * fq;
#pragma unroll
        for (int eb = 0; eb < 4; ++eb) { const f32x4 g = *(const f32x4*)(F.onr() + 64 * h + 16 * eb + 4 * fq);
            u32x2v w; w.x = pk2(yv[tb][eb][0] * rinv * g.x, yv[tb][eb][1] * rinv * g.y); w.y = pk2(yv[tb][eb][2] * rinv * g.z, yv[tb][eb][3] * rinv * g.w); *(u32x2v*)(orow + 16 * eb) = w; }
    }
    if (fr == 0 && (u.kind == 1 || u.j == 63)) {
        float* ho = F.out + (u.kind == 1 ? O_H_S : O_H_P) + (size_t)u.b * DR;
#pragma unroll
        for (int eb = 0; eb < 4; ++eb) { const float* p = F.AGG() + ((size_t)uid * DR + 64 * h + 16 * eb + 4 * fq) * 2; const f32x4 a = *(const f32x4*)p, b = *(const f32x4*)(p + 4);
            *(f32x4*)(ho + 64 * h + 16 * eb + 4 * fq) = (f32x4){a.x * Hin[eb][0] + a.y, a.z * Hin[eb][1] + a.w, b.x * Hin[eb][2] + b.y, b.z * Hin[eb][3] + b.w}; }
    }
    __syncthreads();
}
template <int N> __device__ __forceinline__ float xreduce(float (&v)[N], int lane) {
#pragma unroll
    for (int half = N / 2, off = 32; half >= 1; half >>= 1, off >>= 1) {
        const bool up = (lane & off) != 0;
#pragma unroll
        for (int i = 0; i < half; ++i) { const float send = up ? v[i] : v[i + half], keep = up ? v[i + half] : v[i]; v[i] = keep + __shfl_xor(send, off); }
    }
    float r = v[0];
#pragma unroll
    for (int off = 32 / N; off >= 1; off >>= 1) r += __shfl_xor(r, off);
    return r;
}
__device__ __forceinline__ void conv_unit(Frame& F, int uid) {
    const SeqUnit u = seq_unit(uid);
    const int lane = F.lane, tg = F.wave >> 2, cg = F.wave & 3, c0_ = 128 * cg + 2 * lane;
    LAS float* red1 = (LAS float*)(F.lds);
    LAS float* red2 = (LAS float*)(F.lds + 512);
    LAS unsigned char* vt = F.lds + 8192;
    {   v4u val[12];
#pragma unroll
        for (int i = 0; i < 12; ++i) { const int r = F.wave + NWAVES * i, sv = u.t0 - 30 + r;
            const bool ok = r < 94 && (sv >= 0 || (u.kind == 0 && NMETA + sv >= 0));
            const size_t grow = sv >= 0 ? (size_t)(u.row0 + sv) : (size_t)(ROW_META + NMETA + sv);
            val[i] = *(const v4u*)(F.V() + (ok ? grow : 0) * ZCOLS + 8 * lane);
            if (!ok) val[i] = (v4u){0u, 0u, 0u, 0u}; }
#pragma unroll
        for (int i = 0; i < 12; ++i) { const int r = F.wave + NWAVES * i; if (r < 94) *(LAS v4u*)(vt + r * 1024 + 16 * lane) = val[i]; }
        if (u.kind == 1) {
#pragma unroll
            for (int i = 0; i < 4; ++i) { const int r = F.wave + NWAVES * i;
                if (r < 30) { const float* p = F.st_dw + (size_t)(u.b * 30 + r) * DC + 8 * lane; const f32x4 a = *(const f32x4*)p, b = *(const f32x4*)(p + 4);
                    v4u w; w.x = pk2(a.x, a.y); w.y = pk2(a.z, a.w); w.z = pk2(b.x, b.y); w.w = pk2(b.z, b.w); *(LAS v4u*)(vt + r * 1024 + 16 * lane) = w; } }
        }
    }
    f32x2v w[31];
    unsigned cb4 = (unsigned)c0_ * 4u; asm volatile("" : "+v"(cb4));
#pragma unroll
    for (int k = 0; k < 31; ++k) w[k] = *(const f32x2v*)((const char*)(F.dww() + k * DC) + cb4);
    const f32x2v bias = *(const f32x2v*)((const char*)F.dwb() + cb4), lg = *(const f32x2v*)((const char*)F.lng() + cb4), lb = *(const f32x2v*)((const char*)F.lnb() + cb4), og = *(const f32x2v*)((const char*)F.onc() + cb4);
    __syncthreads();
#pragma unroll 1
    for (int bb = 0; bb < 4; ++bb) {
        const int rb = 32 * tg + 8 * bb;
        const int tb0 = u.t0 + rb;
        int c0 = c0_; asm volatile("" : "+v"(c0));
        f32x2v vc[8]; float st[16];
#pragma unroll
        for (int j = 0; j < 8; ++j) vc[j] = bias;
        const LAS unsigned char* vp = vt + rb * 1024 + 2 * c0;
#pragma unroll
        for (int i = 0; i < 38; ++i) { const unsigned xw = *(const LAS unsigned*)(vp + i * 1024); const f32x2v x = {bf_lo(xw), bf_hi(xw)};
#pragma unroll
            for (int j = 0; j < 8; ++j) { const int k = i - j; if (k >= 0 && k < 31) vc[j] += w[k] * x; }
            if ((i & 7) == 7) asm volatile("" ::: "memory"); }
#pragma unroll
        for (int j = 0; j < 8; ++j) { const f32x2v a = vc[j]; st[j] = a.x + a.y; st[8 + j] = a.x * a.x + a.y * a.y; }
        { const float tot = xreduce<16>(st, lane); if ((lane & 3) == 0) red1[(tg * 16 + ((lane >> 2) & 15)) * 4 + cg] = tot; }
        __syncthreads();
        float q[8];
#pragma unroll
        for (int j = 0; j < 8; ++j) {
            const f32x4 a = *(const LAS f32x4*)(red1 + (tg * 16 + j) * 4), b = *(const LAS f32x4*)(red1 + (tg * 16 + 8 + j) * 4);
            const float mean = ((a.x + a.y) + (a.z + a.w)) * (1.0f / DC), ex2 = ((b.x + b.y) + (b.z + b.w)) * (1.0f / DC);
            const float rstd = 1.0f / sqrtf(fmaxf(ex2 - mean * mean, 0.f) + EPS);
            f32x2v y = (vc[j] - mean) * rstd * lg + lb; y.x *= sigm(y.x); y.y *= sigm(y.y);
            vc[j] = y; q[j] = y.x * y.x + y.y * y.y; }
        { const float tot = xreduce<8>(q, lane); if ((lane & 7) == 0) red2[(tg * 8 + ((lane >> 3) & 7)) * 4 + cg] = tot; }
        __syncthreads();
#pragma unroll
        for (int j = 0; j < 8; ++j) {
            const f32x4 a = *(const LAS f32x4*)(red2 + (tg * 8 + j) * 4);
            const float rinv = 1.0f / sqrtf(((a.x + a.y) + (a.z + a.w)) * (1.0f / DC) + EPS);
            const f32x2v y = vc[j] * rinv * og;
            *(unsigned*)(F.MIX() + (size_t)(u.row0 + tb0 + j) * D + DR + c0) = pk2(y.x, y.y); }
    }
}
__device__ __forceinline__ void state_copy(Frame& F) {
    const int gt = F.bid * (NWAVES * 64) + F.tid, NGT = F.G * NWAVES * 64;
    constexpr int NC = (NB + SB) * 3 * DR, NDW = (NB + SB) * 30 * DC;
    for (int i = gt; i < NC + NDW; i += NGT) {
        if (i < NC) { const int c = i & 511, j = (i >> 9) % 3, sq = (i >> 9) / 3;
            if (sq < NB) F.out[O_CONV_P + (size_t)(sq * 3 + j) * DR + c] = bf_lo(F.XR()[(size_t)(sq * SEQ + SEQ - 3 + j) * ZCOLS + c]);
            else { const int b = sq - NB; F.out[O_CONV_S + (size_t)(b * 3 + j) * DR + c] = bf_lo(F.XR()[(size_t)(M_PROMPT + b * SS + SS - 3 + j) * ZCOLS + c]); }
        } else { const int i2 = i - NC, c = i2 & 511, j = (i2 >> 9) % 30, sq = (i2 >> 9) / 30;
            if (sq < NB) F.out[O_DW_P + (size_t)(sq * 30 + j) * DC + c] = bf_lo(F.V()[(size_t)(sq * SEQ + SEQ - 30 + j) * ZCOLS + c]);
            else { const int b = sq - NB; F.out[O_DW_S + (size_t)(b * 30 + j) * DC + c] = bf_lo(F.V()[(size_t)(M_PROMPT + b * SS + SS - 30 + j) * ZCOLS + c]); }
        }
    }
}
template <int MT, int NT, int KW  , int MODE>
__device__ __forceinline__ void rgemm_tile(Frame& F, const bf16* A, const bf16* Bt, int row0, int b0, int bhalf, int ctile) {
    constexpr int K = KW * 8, NF = MT * NT;
    const int lane = F.lane, wv = F.wave; int fr = lane & 15, fq = lane >> 4;
    asm volatile("" : "+v"(fr), "+v"(fq));
    f32x4 acc[MT][NT];
#pragma unroll
    for (int m = 0; m < MT; ++m)
#pragma unroll
        for (int n = 0; n < NT; ++n) acc[m][n] = (f32x4){0.f, 0.f, 0.f, 0.f};
    const unsigned koff = (unsigned)(wv * KW + 8 * fq);
    unsigned aoff[MT], boff[NT];
#pragma unroll
    for (int m = 0; m < MT; ++m) aoff[m] = ((unsigned)(row0 + 16 * m + fr) * (unsigned)K + koff) * 2u;
#pragma unroll
    for (int n = 0; n < NT; ++n) boff[n] = ((unsigned)(b0 + 16 * (n % (NT / 2)) + (n / (NT / 2)) * bhalf + fr) * (unsigned)K + koff) * 2u;
#pragma unroll 4
    for (int kk = 0; kk < KW; kk += 32) {
        bf16x8 a[MT], b[NT];
#pragma unroll
        for (int m = 0; m < MT; ++m) a[m] = *(const bf16x8*)((const char*)A + aoff[m] + kk * 2);
#pragma unroll
        for (int n = 0; n < NT; ++n) b[n] = *(const bf16x8*)((const char*)Bt + boff[n] + kk * 2);
#pragma unroll
        for (int m = 0; m < MT; ++m)
#pragma unroll
            for (int n = 0; n < NT; ++n) acc[m][n] = __builtin_amdgcn_mfma_f32_16x16x32_bf16(b[n], a[m], acc[m][n], 0, 0, 0);
    }
    LAS f32x4* red = (LAS f32x4*)F.lds;
#pragma unroll
    for (int m = 0; m < MT; ++m)
#pragma unroll
        for (int n = 0; n < NT; ++n) red[(wv * NF + m * NT + n) * 64 + lane] = acc[m][n];
    __syncthreads();
    const int r = F.tid >> 4, q0 = F.tid & 15;
    static_assert(MT == 2, "thread -> row mapping assumes a 32-row tile");
    const int m = r >> 4, lrow = r & 15; const size_t R = (size_t)row0 + r;
    float ss = 0.f;
#pragma unroll
    for (int i = 0; i < NT / 4; ++i) {
        const int q = q0 + 16 * i, n = q >> 2, ln = lrow + 16 * (q & 3);
        if (MODE == 0 && bhalf != 16 * (NT / 2) && n >= NT / 2) continue;
        f32x4 v = {0.f, 0.f, 0.f, 0.f}, g = {0.f, 0.f, 0.f, 0.f};
#pragma unroll
        for (int w = 0; w < 8; ++w) v += red[(w * NF + m * NT + n) * 64 + ln];
        if (MODE == 0) {
            const bool glu = bhalf != 16 * (NT / 2);
            if (glu) {
#pragma unroll
                for (int w = 0; w < 8; ++w) g += red[(w * NF + m * NT + n + NT / 2) * 64 + ln];
#pragma unroll
                for (int j = 0; j < 4; ++j) v[j] *= sigm(g[j]);
                u32x2v w2; w2.x = pk2(v[0], v[1]); w2.y = pk2(v[2], v[3]); *(u32x2v*)(F.V() + R * ZCOLS + 32 * (ctile - 16) + 4 * q) = w2;
            } else {
                bf16* dst = ctile < 8 ? F.XR() + R * ZCOLS + 64 * ctile : F.GG() + R * ZCOLS + 64 * (ctile - 8);
                if (ctile >= 8) {
#pragma unroll
                    for (int j = 0; j < 4; ++j) v[j] = pg8::gelu_tanh(v[j]); }
                u32x2v w2; w2.x = pk2(v[0], v[1]); w2.y = pk2(v[2], v[3]); *(u32x2v*)(dst + 4 * q) = w2;
            }
        } else if (MODE == 1 || MODE == 3) {
            const int col = 16 * NT * ctile + 4 * q;
            const float* xin = MODE == 1 ? F.x_sample + (R - M_PROMPT) * D + col : F.out + R * D + col;
            const f32x4 o = *(const f32x4*)xin + v;
            *(f32x4*)(F.out + R * D + col) = o; ss += (o[0] * o[0] + o[1] * o[1]) + (o[2] * o[2] + o[3] * o[3]);
            if (MODE == 1) { u32x2v w2; w2.x = pk2(o[0], o[1]); w2.y = pk2(o[2], o[3]); *(u32x2v*)(F.X1B() + R * D + col) = w2; }
        } else {
            const float* sp = F.SSQ1() + R * 16; const f32x4 p0 = *(const f32x4*)sp, p1 = *(const f32x4*)(sp + 4), p2 = *(const f32x4*)(sp + 8), p3 = *(const f32x4*)(sp + 12);
            const f32x4 ps = (p0 + p1) + (p2 + p3); const float rinv = 1.0f / sqrtf(((ps[0] + ps[1]) + (ps[2] + ps[3])) * (1.0f / D) + EPS);
#pragma unroll
            for (int j = 0; j < 4; ++j) { const float t = fmaxf(v[j] * rinv, 0.f); v[j] = t * t; }
            u32x2v w2; w2.x = pk2(v[0], v[1]); w2.y = pk2(v[2], v[3]); *(u32x2v*)(F.U() + R * FF + 16 * NT * ctile + 4 * q) = w2;
        }
    }
    if (MODE == 1 || MODE == 3) {
        ss += __shfl_xor(ss, 1); ss += __shfl_xor(ss, 2); ss += __shfl_xor(ss, 4); ss += __shfl_xor(ss, 8);
        if (q0 == 0) (MODE == 1 ? F.SSQ1() : F.SSQ2())[R * 16 + ctile] = ss;
    }
    __syncthreads();
}
__device__ __forceinline__ void final_norm(Frame& F) {
    const int gw = F.bid * NWAVES + F.wave, NGW = F.G * NWAVES, lane = F.lane;
    for (int m = gw; m < M_MAIN; m += NGW) {
        const float p = lane < 16 ? F.SSQ2()[(size_t)m * 16 + lane] : 0.f;
        const float rinv = 1.0f / sqrtf(wave_sum(p) * (1.0f / D) + EPS);
        GAS f32x4* xr = (GAS f32x4*)(F.out + (size_t)m * D) + lane; const GAS f32x4* gr = (const GAS f32x4*)F.norm_final() + lane;
        f32x4 v[4];
#pragma unroll
        for (int j = 0; j < 4; ++j) v[j] = xr[64 * j];
#pragma unroll
        for (int j = 0; j < 4; ++j) xr[64 * j] = v[j] * rinv * gr[64 * j];
    }
}
struct Args { const float* in[26]; float* out; unsigned char* ws; };
__global__ void __launch_bounds__(NWAVES * 64, 2) hymba_fwd(Args args) {
    __shared__ __attribute__((aligned(16))) unsigned char lds_raw[LDS_BYTES];
    Frame F;
    F.lds = (LAS unsigned char*)lds_raw;
    F.tid = threadIdx.x; F.lane = F.tid & 63; F.wave = __builtin_amdgcn_readfirstlane(F.tid >> 6); F.G = gridDim.x; F.bid = blockIdx.x;
    unsigned char* ws = args.ws; F.ws = ws; F.out = args.out;
    F.x_prompt = args.in[0]; F.x_sample = args.in[1]; F.st_conv = args.in[2]; F.st_h = args.in[3]; F.st_dw = args.in[4];
    volatile LAS unsigned* MISC = (volatile LAS unsigned*)(F.lds + MISC_OFF);
    if (F.tid < 64) MISC[F.tid] = 0u;
    __syncthreads();
    XcdBarrier bar = xcd_barrier_post((unsigned*)(ws + WS_CTL) + CW_BAR, MISC + 8);
#ifndef PHMASK
#define PHMASK 0xFF
#endif
#ifndef DUP_MASK
#define DUP_MASK 0
#endif
#define IN(k) ((PHMASK >> (k)) & 1)
#define REP(k) for (int rep_ = 0; rep_ < 1 + ((DUP_MASK >> (k)) & 1); ++rep_)
#define PHASE_BEGIN() asm volatile("" : "+s"(F.ws), "+s"(F.out), "+v"(F.tid), "+v"(F.lane))
#define SEAM(k) do { if (IN(k) && IN((k) + 1)) xcd_barrier(bar); } while (0)
    if (IN(0)) REP(0) { PHASE_BEGIN(); p0_prologue(F, args); } SEAM(0);
    if (IN(1)) REP(1) { PHASE_BEGIN(); pg8::Gemm g{F.HN(), F.W1t(), M_PROMPT, DIN, D}; pg8::StaticOrder S; S.init(M_PROMPT, DIN, F.G, F.bid); pg8::EpiZ E{F.XR(), F.GG(), F.V()};
        pg8::gemm_phase<pg8::EpiZ, pg8::StaticOrder, true, true>(F.lds, g, S, E);
#pragma unroll 1
        for (int t = F.bid; t < 17 * 32; t += F.G) { const int rt = t >> 5, ct = t & 31; int b0, bhalf = 32;
            if (ct < 16) b0 = 64 * ct; else { const int vt = ct - 16; b0 = 1024 + 256 * (vt >> 2) + 32 * (vt & 3); bhalf = 128; }
            rgemm_tile<2, 4, D / 8, 0>(F, F.HN(), F.W1t(), M_PROMPT + 32 * rt, b0, bhalf, ct); }
    } SEAM(1);
    if (IN(2)) REP(2) { PHASE_BEGIN();
        __syncthreads();
        rnn_pass1(F);
        __syncthreads();
        for (int uu = F.bid; uu < 264; uu += F.G) conv_unit(F, uu);
        state_copy(F); } SEAM(2);
    if (IN(3)) REP(3) { PHASE_BEGIN(); for (int uu = F.bid; uu < 264; uu += F.G) rnn_pass2(F, uu); } SEAM(3);
    if (IN(4)) REP(4) { PHASE_BEGIN(); pg8::Gemm g{F.MIX(), F.Wot(), M_PROMPT, D, D}; pg8::StaticOrder S; S.init(M_PROMPT, D, F.G, F.bid); pg8::EpiRes<true> E{F.x_prompt, F.x_sample, M_PROMPT / 256, F.out, F.X1B(), F.SSQ1()};
        pg8::gemm_phase<pg8::EpiRes<true>, pg8::StaticOrder, true, true>(F.lds, g, S, E);
#pragma unroll 1
        for (int t = F.bid; t < 16 * 16; t += F.G) rgemm_tile<2, 4, D / 8, 1>(F, F.MIX(), F.Wot(), M_PROMPT + 32 * (t >> 4), 64 * (t & 15), 32, t & 15);
    } SEAM(4);
    if (IN(5)) REP(5) { PHASE_BEGIN(); pg8::Gemm g{F.X1B(), F.Wupt(), M_PROMPT, FF, D}; pg8::StaticOrder S; S.init(M_PROMPT, FF, F.G, F.bid); pg8::EpiU E{F.SSQ1(), F.U(), FF};
        pg8::gemm_phase<pg8::EpiU, pg8::StaticOrder, true, true>(F.lds, g, S, E);
#pragma unroll 1
        for (int t = F.bid; t < 16 * 32; t += F.G) rgemm_tile<2, 8, D / 8, 2>(F, F.X1B(), F.Wupt(), M_PROMPT + 32 * (t >> 5), 128 * (t & 31), 64, t & 31);
    } SEAM(5);
    if (IN(6)) { PHASE_BEGIN(); pg8::Gemm g{F.U(), F.Wdt(), M_PROMPT, D, FF}; pg8::StaticOrder S; S.init(M_PROMPT, D, F.G, F.bid); pg8::EpiRes<false> E{F.out, F.out, 1 << 20, F.out, nullptr, F.SSQ2()};
        pg8::gemm_phase<pg8::EpiRes<false>, pg8::StaticOrder, true, true>(F.lds, g, S, E);
#pragma unroll 1
        for (int t = F.bid; t < 16 * 16; t += F.G) rgemm_tile<2, 4, FF / 8, 3>(F, F.U(), F.Wdt(), M_PROMPT + 32 * (t >> 4), 64 * (t & 15), 32, t & 15);
    } SEAM(6);
    if (IN(7)) { PHASE_BEGIN(); final_norm(F); }
#undef IN
#undef SEAM
}
extern "C" void kernel_launch(void* const* d_in, const int* in_sizes, int n_in, void* d_out, int out_size, void* d_ws, size_t ws_size, hipStream_t stream) {
    static int grid = 0;
    if (grid == 0) {
        if (n_in != 26 || out_size != (int)O_END || ws_size < WS_END) { fprintf(stderr, "kernel_launch: unexpected shapes (n_in %d, out %d, ws %zu)\n", n_in, out_size, ws_size); grid = -1; return; }
        int dev = 0, cus = 0, per_cu = 0;
        if (hipGetDevice(&dev) != hipSuccess || hipDeviceGetAttribute(&cus, hipDeviceAttributeMultiprocessorCount, dev) != hipSuccess) { grid = -1; return; }
        if (hipOccupancyMaxActiveBlocksPerMultiprocessor(&per_cu, (const void*)hymba_fwd, NWAVES * 64, 0) != hipSuccess || per_cu < 1) { fprintf(stderr, "kernel_launch: occupancy query says %d blocks per CU\n", per_cu); (void)hipGetLastError(); grid = -1; return; }
        grid = cus;
    }
    if (grid < 0) return;
    if (hipMemsetAsync((char*)d_ws + WS_CTL, 0, CTL_ZERO_BYTES, stream) != hipSuccess) return;
    Args a{};
    for (int i = 0; i < 26; ++i) a.in[i] = (const float*)d_in[i];
    a.out = (float*)d_out; a.ws = (unsigned char*)d_ws;
    hipLaunchKernelGGL(hymba_fwd, dim3(grid), dim3(NWAVES * 64), 0, stream, a);
}
```

```cpp
#include <hip/hip_runtime.h>
#include <cstdio>
#include <cstdint>
#include <cmath>
namespace pg8 {
#define PG8_LAS __attribute__((address_space(3)))
typedef unsigned short bf16_t;
typedef short bf16x8 __attribute__((ext_vector_type(8)));
typedef float f32x4 __attribute__((ext_vector_type(4)));
typedef unsigned u32x4 __attribute__((ext_vector_type(4)));
constexpr int BM = 256, BK = 64, HALF = 128, HTB = HALF * BK * 2  , STAGE_BYTES = 8 * HTB, NXCD = 8, WGM = 8;

__host__ __device__ __forceinline__ int lds_byte(int r, int c) { const int st = (r >> 4) * 2 + (c >> 5), rr = r & 15, cc = c & 31, ob = rr * 64 + cc * 2; return st * 1024 + (ob ^ (((ob >> 9) & 1) << 5)); }
__host__ __device__ __forceinline__ void stage_rc(int b, int& R, int& C) { const int st = b / 1024, sb = b % 1024, swz = sb ^ (((sb >> 9) & 1) << 5); R = (st >> 1) * 16 + swz / 64; C = (st & 1) * 32 + (swz % 64) / 2; }
__host__ __device__ __forceinline__ int perm32(int rho) { const int n = rho >> 4, i = rho & 15; return 8 * (i >> 2) + 4 * n + (i & 3); }

struct Unit { int pm, pn; };
struct Gemm { const bf16_t* A; const bf16_t* Bt; int M, N, K; };

struct StaticOrder {
    int nM, nN, nwg, G, c;
    __host__ __device__ void init(int M, int N, int G_, int c_) { nM = M / BM; nN = N / BM; nwg = nM * nN; G = G_; c = c_; }
    __host__ __device__ bool next(int i, Unit& u) const {
        const long L = (long)i * G + c; if (L >= nwg) return false;
        int wgid = (int)L; { const int q = nwg / NXCD, r = nwg % NXCD, xcd = wgid % NXCD, off = wgid / NXCD; wgid = (xcd < r ? xcd * (q + 1) : r * (q + 1) + (xcd - r) * q) + off; }
        const int nig = WGM * nN, gid = wgid / nig, fm = gid * WGM, gsz = (nM - fm) < WGM ? (nM - fm) : WGM;
        u.pm = fm + ((wgid % nig) % gsz); u.pn = (wgid % nig) / gsz; return true;
    }
    __device__ __forceinline__ void a_ready(const Unit&) const {}
    __device__ __forceinline__ void done(const Unit&) const {}
};

__device__ __forceinline__ unsigned cvt_pk_bf16(float lo, float hi) { unsigned r; asm volatile("v_cvt_pk_bf16_f32 %0, %1, %2" : "=v"(r) : "v"(lo), "v"(hi)); return r; }
typedef float f32x2 __attribute__((ext_vector_type(2)));
__device__ __forceinline__ float fast_sigmoid(float x) { return __builtin_amdgcn_rcpf(1.0f + __builtin_amdgcn_exp2f(-1.4426950408889634f * x)); }
__device__ __forceinline__ float gelu_tanh(float x) {
    const float t = x * (1.0f + 0.044715f * x * x);
    return x * __builtin_amdgcn_rcpf(1.0f + __builtin_amdgcn_exp2f(-2.3022081985f * t));
}
constexpr int ZC = 512;
struct EpiZ {
    static constexpr bool PERM = true, AFTER_DRAIN = false;
    bf16_t *XR, *GG, *V;
    __device__ __forceinline__ void operator()(const f32x4 (&acc)[2][2][4][2], const Unit& u, int wr, int wc, int fr, int fq) const {
        const int row0 = u.pm * BM + wr * 64 + fr, cw = wc * 32 + 8 * fq;
        if (u.pn < 4) {
            bf16_t* base = (u.pn < 2 ? XR : GG) + (u.pn & 1) * 256 + cw; const bool act = u.pn >= 2;
#pragma unroll
            for (int ai = 0; ai < 2; ++ai)
#pragma unroll
                for (int m = 0; m < 4; ++m) { bf16_t* rowp = base + (size_t)(row0 + ai * HALF + m * 16) * ZC;
#pragma unroll
                    for (int bj = 0; bj < 2; ++bj) { f32x4 v0 = acc[ai][bj][m][0], v1 = acc[ai][bj][m][1];
                        if (act) {
#pragma unroll
                            for (int j = 0; j < 4; ++j) { v0[j] = gelu_tanh(v0[j]); v1[j] = gelu_tanh(v1[j]); } }
                        u32x4 w; w.x = cvt_pk_bf16(v0[0], v0[1]); w.y = cvt_pk_bf16(v0[2], v0[3]); w.z = cvt_pk_bf16(v1[0], v1[1]); w.w = cvt_pk_bf16(v1[2], v1[3]);
                        *(u32x4*)(rowp + bj * HALF) = w; } }
        } else {
            bf16_t* base = V + (u.pn - 4) * 128 + cw;
#pragma unroll
            for (int ai = 0; ai < 2; ++ai)
#pragma unroll
                for (int m = 0; m < 4; ++m) { bf16_t* rowp = base + (size_t)(row0 + ai * HALF + m * 16) * ZC;
                    f32x4 v0 = acc[ai][0][m][0], v1 = acc[ai][0][m][1]; const f32x4 g0 = acc[ai][1][m][0], g1 = acc[ai][1][m][1];
#pragma unroll
                    for (int j = 0; j < 4; ++j) { v0[j] *= fast_sigmoid(g0[j]); v1[j] *= fast_sigmoid(g1[j]); }
                    u32x4 w; w.x = cvt_pk_bf16(v0[0], v0[1]); w.y = cvt_pk_bf16(v0[2], v0[3]); w.z = cvt_pk_bf16(v1[0], v1[1]); w.w = cvt_pk_bf16(v1[2], v1[3]);
                    *(u32x4*)rowp = w; }
        }
    }
};
typedef unsigned u32x2 __attribute__((ext_vector_type(2)));
template <bool WITH_BF16> struct EpiRes {
    static constexpr bool PERM = false, AFTER_DRAIN = false;
    const float* xa; const float* xb; int pm_split;
    float* X1; bf16_t* X1B; float* SSQ;
    __device__ __forceinline__ void operator()(const f32x4 (&acc)[2][2][4][2], const Unit& u, int wr, int wc, int fr, int fq) const {
        const float* xin = (u.pm < pm_split) ? xa + (size_t)u.pm * BM * 1024 : xb + (size_t)(u.pm - pm_split) * BM * 1024;
        const int col0 = u.pn * BM + wc * 32 + 4 * fq;
#pragma unroll
        for (int ai = 0; ai < 2; ++ai)
#pragma unroll
            for (int m = 0; m < 4; ++m) { const int rl = ai * HALF + wr * 64 + m * 16 + fr; const size_t R = (size_t)u.pm * BM + rl; float s = 0.f;
#pragma unroll
                for (int bj = 0; bj < 2; ++bj)
#pragma unroll
                    for (int n = 0; n < 2; ++n) { const int off = col0 + bj * HALF + n * 16; const f32x4 xv = *(const f32x4*)(xin + (size_t)rl * 1024 + off); const f32x4 o = xv + acc[ai][bj][m][n];
                        *(f32x4*)(X1 + R * 1024 + off) = o; s += (o[0] * o[0] + o[1] * o[1]) + (o[2] * o[2] + o[3] * o[3]);
                        if (WITH_BF16) { u32x2 w; w.x = cvt_pk_bf16(o[0], o[1]); w.y = cvt_pk_bf16(o[2], o[3]); *(u32x2*)(X1B + R * 1024 + off) = w; } }
                s += __shfl_xor(s, 16); s += __shfl_xor(s, 32);
                if (fq == 0) SSQ[R * 16 + u.pn * 4 + wc] = s;
                asm volatile("" ::: "memory"); }
    }
};
struct EpiU {
    static constexpr bool PERM = true, AFTER_DRAIN = false;
    const float* SSQ; bf16_t* U; int ldc;
    __device__ __forceinline__ void operator()(const f32x4 (&acc)[2][2][4][2], const Unit& u, int wr, int wc, int fr, int fq) const {
        const int row0 = u.pm * BM + wr * 64 + fr, col0 = u.pn * BM + wc * 32 + 8 * fq;
#pragma unroll
        for (int ai = 0; ai < 2; ++ai)
#pragma unroll
            for (int m = 0; m < 4; ++m) { const size_t R = (size_t)(row0 + ai * HALF + m * 16);
                const f32x4 p0 = *(const f32x4*)(SSQ + R * 16), p1 = *(const f32x4*)(SSQ + R * 16 + 4), p2 = *(const f32x4*)(SSQ + R * 16 + 8), p3 = *(const f32x4*)(SSQ + R * 16 + 12);
                const f32x4 ps = (p0 + p1) + (p2 + p3); const float rinv = __builtin_amdgcn_rsqf(((ps[0] + ps[1]) + (ps[2] + ps[3])) * (1.0f / 1024.0f) + 1e-6f);
                bf16_t* rowp = U + R * ldc + col0;
#pragma unroll
                for (int bj = 0; bj < 2; ++bj) { f32x4 v0 = acc[ai][bj][m][0] * rinv, v1 = acc[ai][bj][m][1] * rinv;
#pragma unroll
                    for (int j = 0; j < 4; ++j) { const float a = fmaxf(v0[j], 0.f), b = fmaxf(v1[j], 0.f); v0[j] = a * a; v1[j] = b * b; }
                    u32x4 w; w.x = cvt_pk_bf16(v0[0], v0[1]); w.y = cvt_pk_bf16(v0[2], v0[3]); w.z = cvt_pk_bf16(v1[0], v1[1]); w.w = cvt_pk_bf16(v1[2], v1[3]);
                    *(u32x4*)(rowp + bj * HALF) = w; } }
    }
};
template <class Epi, class Sched, bool ALIGN_EPI = false, bool SP2 = false>
__device__ __forceinline__ void gemm_phase(PG8_LAS unsigned char* lds, const Gemm g, const Sched& S, const Epi& E) {
    int tid_ = threadIdx.x; asm volatile("" : "+v"(tid_));
    const int tid = tid_, wid = __builtin_amdgcn_readfirstlane(tid >> 6), lane = tid & 63, wr = wid >> 2, wc = wid & 3, fr = lane & 15, fq = lane >> 4;
    const int K = g.K, nt = K / BK;
    unsigned voffA[2], voffB[2];
#pragma unroll
    for (int i = 0; i < 2; ++i) { int R, C; stage_rc(tid * 16 + i * 8192, R, C); const int Rb = Epi::PERM ? ((R & ~31) + perm32(R & 31)) : R;
        voffA[i] = (unsigned)(R * K + C) * 2u; voffB[i] = (unsigned)(Rb * K + C) * 2u; }
    const size_t kstep = (size_t)(BK * 2);
    const size_t hstep = (size_t)HALF * K * 2;
    const size_t tstep = 2 * hstep;
    const unsigned ldsw = (unsigned)wid * 1024u;
    const int aoff = lds_byte(wr * 64 + fr, fq * 8), boff = lds_byte(wc * 32 + fr, fq * 8);
#define PG8_SA(b, h) (((b) * 2 + (h)) * HTB)
#define PG8_SB(b, h) ((4 + (b) * 2 + (h)) * HTB)
#define PG8_STAGE(bufoff, gbase, voff) do { _Pragma("unroll") for (int _i = 0; _i < 2; ++_i) \
        __builtin_amdgcn_global_load_lds((const unsigned*)((const char*)(gbase) + (voff)[_i]), (PG8_LAS unsigned*)(lds + (bufoff) + ldsw + _i * 8192), 16, 0, 0); } while (0)
#define PG8_LDA(dst, b, h) do { _Pragma("unroll") for (int m = 0; m < 4; ++m) _Pragma("unroll") for (int k = 0; k < 2; ++k) dst[m][k] = *(const PG8_LAS bf16x8*)(lds + PG8_SA(b, h) + aoff + m * 2048 + k * 1024); } while (0)
#define PG8_LDB(dst, b, h) do { _Pragma("unroll") for (int n = 0; n < 2; ++n) _Pragma("unroll") for (int k = 0; k < 2; ++k) dst[n][k] = *(const PG8_LAS bf16x8*)(lds + PG8_SB(b, h) + boff + n * 2048 + k * 1024); } while (0)
#define PG8_MMA(ai, bj, At, Bt) do { __builtin_amdgcn_s_setprio(1); _Pragma("unroll") for (int m = 0; m < 4; ++m) _Pragma("unroll") for (int n = 0; n < 2; ++n) _Pragma("unroll") for (int k = 0; k < 2; ++k) \
        acc[ai][bj][m][n] = __builtin_amdgcn_mfma_f32_16x16x32_bf16(Bt[n][k], At[m][k], acc[ai][bj][m][n], 0, 0, 0); __builtin_amdgcn_s_setprio(0); } while (0)
#define PG8_WAIT_V(n) asm volatile("s_waitcnt vmcnt(" #n ")" ::: "memory")
#define PG8_WAIT_L(n) asm volatile("s_waitcnt lgkmcnt(" #n ")" ::: "memory")
#define PG8_BAR __builtin_amdgcn_s_barrier()
#define PG8_SCHED __builtin_amdgcn_sched_barrier(0)
    Unit cur, nxt; int ui = 0;
    if (!S.next(0, cur)) return;
    f32x4 acc[2][2][4][2];
#pragma unroll
    for (int a = 0; a < 2; ++a)
#pragma unroll
        for (int b = 0; b < 2; ++b)
#pragma unroll
            for (int m = 0; m < 4; ++m)
#pragma unroll
                for (int n = 0; n < 2; ++n) acc[a][b][m][n] = (f32x4){0.f, 0.f, 0.f, 0.f};
    bf16x8 At[4][2], B0[2][2], B1[2][2];
    const char* cA = (const char*)g.A + (size_t)cur.pm * tstep; const char* cB = (const char*)g.Bt + (size_t)cur.pn * tstep;
    S.a_ready(cur);
    if constexpr (SP2) {
        PG8_STAGE(PG8_SB(0, 0), cB, voffB); PG8_STAGE(PG8_SB(0, 1), cB + hstep, voffB); PG8_STAGE(PG8_SA(0, 0), cA, voffA); PG8_STAGE(PG8_SA(0, 1), cA + hstep, voffA);
        if (wr == 1) PG8_BAR;
        PG8_WAIT_V(2); PG8_BAR;
        PG8_STAGE(PG8_SB(1, 0), cB + kstep, voffB); PG8_STAGE(PG8_SA(1, 0), cA + kstep, voffA); PG8_STAGE(PG8_SB(1, 1), cB + hstep + kstep, voffB);
        PG8_WAIT_V(6); PG8_BAR;
    } else {
        PG8_STAGE(PG8_SB(0, 0), cB, voffB); PG8_STAGE(PG8_SA(0, 0), cA, voffA); PG8_STAGE(PG8_SB(0, 1), cB + hstep, voffB); PG8_STAGE(PG8_SA(0, 1), cA + hstep, voffA);
        if (wr == 1) PG8_BAR;
        PG8_WAIT_V(4); PG8_BAR;
        PG8_STAGE(PG8_SB(1, 0), cB + kstep, voffB); PG8_STAGE(PG8_SA(1, 0), cA + kstep, voffA); PG8_STAGE(PG8_SB(1, 1), cB + hstep + kstep, voffB);
        PG8_WAIT_V(6); PG8_BAR;
    }
    for (;;) {
        const bool has_next = S.next(ui + 1, nxt);
        const char* nA = has_next ? (const char*)g.A + (size_t)nxt.pm * tstep : cA; const char* nB = has_next ? (const char*)g.Bt + (size_t)nxt.pn * tstep : cB;
        for (int t = 0; t < nt; t += 2) {
            const bool last = (t == nt - 2);
            const char* a1 = cA + (size_t)(t + 1) * kstep;
            const char* a2 = last ? nA : cA + (size_t)(t + 2) * kstep; const char* b2 = last ? nB : cB + (size_t)(t + 2) * kstep;
            const char* a3 = a2 + kstep; const char* b3 = b2 + kstep;
            if (last && has_next) S.a_ready(nxt);
            if constexpr (SP2) {
            PG8_LDB(B0, 0, 0); PG8_LDB(B1, 0, 1); PG8_SCHED; PG8_LDA(At, 0, 0); PG8_STAGE(PG8_SA(1, 1), a1 + hstep, voffA);
            PG8_WAIT_V(8); PG8_WAIT_L(0); PG8_BAR; PG8_MMA(0, 0, At, B0); PG8_MMA(0, 1, At, B1); PG8_BAR; PG8_SCHED;
            PG8_LDA(At, 0, 1); PG8_STAGE(PG8_SB(0, 0), b2, voffB); PG8_STAGE(PG8_SB(0, 1), b2 + hstep, voffB); PG8_STAGE(PG8_SA(0, 0), a2, voffA);
            PG8_WAIT_V(8); PG8_WAIT_L(0); PG8_BAR; PG8_MMA(1, 0, At, B0); PG8_MMA(1, 1, At, B1); PG8_BAR; PG8_SCHED;
            PG8_LDB(B0, 1, 0); PG8_LDB(B1, 1, 1); PG8_SCHED; PG8_LDA(At, 1, 0); PG8_STAGE(PG8_SA(0, 1), a2 + hstep, voffA);
            PG8_WAIT_V(8); PG8_WAIT_L(0); PG8_BAR; PG8_MMA(0, 0, At, B0); PG8_MMA(0, 1, At, B1); PG8_BAR; PG8_SCHED;
            PG8_LDA(At, 1, 1); PG8_STAGE(PG8_SB(1, 0), b3, voffB); PG8_STAGE(PG8_SB(1, 1), b3 + hstep, voffB); PG8_STAGE(PG8_SA(1, 0), a3, voffA);
            PG8_WAIT_V(8); PG8_WAIT_L(0); PG8_BAR; PG8_MMA(1, 0, At, B0); PG8_MMA(1, 1, At, B1); PG8_BAR; PG8_SCHED;
            } else {
            PG8_LDB(B0, 0, 0); PG8_SCHED; PG8_LDA(At, 0, 0); PG8_STAGE(PG8_SA(1, 1), a1 + hstep, voffA);
            PG8_WAIT_L(8); PG8_BAR; PG8_WAIT_L(0); PG8_MMA(0, 0, At, B0); PG8_BAR; PG8_SCHED;
            PG8_LDB(B1, 0, 1); PG8_STAGE(PG8_SB(0, 0), b2, voffB);
            PG8_BAR; PG8_WAIT_L(0); PG8_MMA(0, 1, At, B1); PG8_BAR;
            PG8_LDA(At, 0, 1); PG8_STAGE(PG8_SA(0, 0), a2, voffA);
            PG8_BAR; PG8_WAIT_L(0); PG8_MMA(1, 0, At, B0); PG8_BAR; PG8_SCHED;
            PG8_STAGE(PG8_SB(0, 1), b2 + hstep, voffB);
            PG8_WAIT_V(6); PG8_BAR; PG8_MMA(1, 1, At, B1); PG8_BAR;
            PG8_LDB(B0, 1, 0); PG8_SCHED; PG8_LDA(At, 1, 0); PG8_STAGE(PG8_SA(0, 1), a2 + hstep, voffA);
            PG8_WAIT_L(8); PG8_BAR; PG8_WAIT_L(0); PG8_MMA(0, 0, At, B0); PG8_BAR; PG8_SCHED;
            PG8_LDB(B1, 1, 1); PG8_STAGE(PG8_SB(1, 0), b3, voffB);
            PG8_BAR; PG8_WAIT_L(0); PG8_MMA(0, 1, At, B1); PG8_BAR;
            PG8_LDA(At, 1, 1); PG8_STAGE(PG8_SA(1, 0), a3, voffA);
            PG8_BAR; PG8_WAIT_L(0); PG8_MMA(1, 0, At, B0); PG8_BAR; PG8_SCHED;
            PG8_STAGE(PG8_SB(1, 1), b3 + hstep, voffB);
            PG8_WAIT_V(6); PG8_BAR; PG8_MMA(1, 1, At, B1); PG8_BAR;
            }
        }
        if constexpr (ALIGN_EPI) { if (wr == 0) PG8_BAR; }
        if constexpr (!Epi::AFTER_DRAIN) { E(acc, cur, wr, wc, fr, fq); S.done(cur); }
        if (!has_next) break;
#pragma unroll
        for (int a = 0; a < 2; ++a)
#pragma unroll
            for (int b = 0; b < 2; ++b)
#pragma unroll
                for (int m = 0; m < 4; ++m)
#pragma unroll
                    for (int n = 0; n < 2; ++n) acc[a][b][m][n] = (f32x4){0.f, 0.f, 0.f, 0.f};
        cur = nxt; cA = nA; cB = nB; ++ui;
        if constexpr (ALIGN_EPI) { if (wr == 1) PG8_BAR; }
    }
    PG8_WAIT_V(0);
    if constexpr (!ALIGN_EPI) { if (wr == 0) PG8_BAR; }
    PG8_BAR;
    if constexpr (Epi::AFTER_DRAIN) { E.fused(acc, cur, wr, wc, fr, fq, lds, wid, lane); S.done(cur); }
#undef PG8_SA
#undef PG8_SB
#undef PG8_STAGE
#undef PG8_LDA
#undef PG8_LDB
#undef PG8_MMA
#undef PG8_WAIT_V
#undef PG8_WAIT_L
#undef PG8_BAR
#undef PG8_SCHED
}
}
#define GAS __attribute__((address_space(1)))
#define LAS __attribute__((address_space(3)))
typedef unsigned short bf16;
typedef unsigned v4u __attribute__((ext_vector_type(4)));
typedef float f32x4 __attribute__((ext_vector_type(4)));
typedef short bf16x8 __attribute__((ext_vector_type(8)));
typedef GAS unsigned gu32;
typedef GAS unsigned long long gu64;
#define RLX_AGENT __ATOMIC_RELAXED, __HIP_MEMORY_SCOPE_AGENT
#define LDS_WAIT() asm volatile("s_waitcnt lgkmcnt(0)" ::: "memory")
#define VM_WAIT() asm volatile("s_waitcnt vmcnt(0)" ::: "memory")
__device__ __forceinline__ unsigned long long rt() { return __builtin_amdgcn_s_memrealtime(); }
__device__ __forceinline__ unsigned f2bf(float f) { unsigned u = __builtin_bit_cast(unsigned, f); return (u + 0x7fffu + ((u >> 16) & 1u)) >> 16; }
__device__ __forceinline__ unsigned pk2(float lo, float hi) { return f2bf(lo) | (f2bf(hi) << 16); }
#define XB_TMO      128
#define XB_XCNT(j)  (256  + 64 * (j))
#define XB_XSUB(j)  (1280 + 64 * (j))
#define XB_XGEN(j)  (2304 + 64 * (j))
#define XB_TOP      3328
#define XB_TOPGEN   3392
#define XCD_BAR_WORDS 3456
#define XB_SPIN_CAP (1u << 18)

__device__ __forceinline__ unsigned xb_ld(unsigned* p)              { return __hip_atomic_load(p, __ATOMIC_RELAXED, __HIP_MEMORY_SCOPE_AGENT); }
__device__ __forceinline__ unsigned xb_add(unsigned* p, unsigned v) { return __hip_atomic_fetch_add(p, v, __ATOMIC_RELAXED, __HIP_MEMORY_SCOPE_AGENT); }
__device__ __forceinline__ unsigned xb_xcc_id() { return (unsigned)__builtin_amdgcn_s_getreg((3 << 11) | 20) & 0xFu; }
#define XB_SPIN(cond, bar) do { unsigned _sp = 0; while (cond) { __builtin_amdgcn_s_sleep(1); \
    if ((++_sp & 255u) == 0u) { if (xb_ld(&(bar)[XB_TMO])) break; if (_sp > XB_SPIN_CAP) { atomicAdd(&(bar)[XB_TMO], 1u); break; } } } } while (0)

struct XcdBarrier {
    unsigned* bar; unsigned x;
    volatile LAS unsigned* st;
};

__device__ __forceinline__ XcdBarrier xcd_barrier_post(unsigned* bar, volatile LAS unsigned* st) {
    XcdBarrier b; b.bar = bar; b.x = xb_xcc_id(); b.st = st;
    if (threadIdx.x == 0) (void)xb_add(&bar[XB_XCNT(b.x)], 1u);
    return b;
}
__device__ __forceinline__ void xcd_barrier_complete(unsigned* bar, unsigned x, unsigned& nloc, unsigned& nx) {
    const unsigned G = gridDim.x * gridDim.y * gridDim.z;
    unsigned sum, cnt, mine, sp = 0u;
    for (;;) {
        sum = 0u; cnt = 0u; mine = 0u;
#pragma unroll
        for (unsigned j = 0; j < 16; ++j) { const unsigned c = xb_ld(&bar[XB_XCNT(j)]); sum += c; cnt += (c > 0u) ? 1u : 0u; mine = (j == x) ? c : mine; }
        if (sum == G) break;
        __builtin_amdgcn_s_sleep(1);
        if ((++sp & 255u) == 0u) { if (xb_ld(&bar[XB_TMO])) break; if (sp > XB_SPIN_CAP) { atomicAdd(&bar[XB_TMO], 1u); break; } }
    }
    nloc = mine > 0u ? mine : 1u; nx = cnt > 0u ? cnt : 1u;
}

__device__ __forceinline__ void xcd_barrier(const XcdBarrier& b) {
    asm volatile("s_waitcnt vmcnt(0)" ::: "memory");
    __syncthreads();
    if (threadIdx.x == 0) {
        unsigned* bar = b.bar;
        __builtin_amdgcn_s_waitcnt(0);
        unsigned nloc = b.st[0], nx = b.st[1];
        if (nloc == 0u) { xcd_barrier_complete(bar, b.x, nloc, nx); b.st[0] = nloc; b.st[1] = nx; }
        const unsigned old = xb_add(&bar[XB_XSUB(b.x)], 1u);
        const unsigned gen = old / nloc;
        if (old + 1u == (gen + 1u) * nloc) {
            __builtin_amdgcn_fence(__ATOMIC_RELEASE, "agent");
            asm volatile("s_waitcnt vmcnt(0)" ::: "memory");
            const unsigned og = xb_add(&bar[XB_TOP], 1u);
            const unsigned tg = og / nx;
            if (og + 1u == (tg + 1u) * nx) xb_add(&bar[XB_TOPGEN], 1u);
            else XB_SPIN(xb_ld(&bar[XB_TOPGEN]) == tg, bar);
            __builtin_amdgcn_fence(__ATOMIC_ACQUIRE, "agent");
            xb_add(&bar[XB_XGEN(b.x)], 1u);
            asm volatile("s_waitcnt vmcnt(0)" ::: "memory");
        } else {
            XB_SPIN(xb_ld(&bar[XB_XGEN(b.x)]) == gen, bar);
            __builtin_amdgcn_fence(__ATOMIC_ACQUIRE, "agent");
            asm volatile("s_waitcnt vmcnt(0)" ::: "memory");
        }
    }
    __syncthreads();
}
constexpr int NWAVES = 8;
constexpr int D = 1024, DIN = 2048, DR = 512, DC = 512, FF = 4096, NH = 8, HD = 64;
constexpr int NB = 4, SEQ = 4096, NMETA = 16, SB = 8, SS = 64;
constexpr int M_PROMPT = NB * SEQ;
constexpr int M_SAMPLE = SB * SS;
constexpr int M_MAIN = M_PROMPT + M_SAMPLE;
constexpr int ROW_META = M_MAIN;
constexpr int M_Z = 67 * 256;
constexpr float EPS = 1e-6f;
constexpr int ZCOLS = 512;
constexpr size_t O_Y = 0;
constexpr size_t O_CONV_P = (size_t)M_MAIN * D;
constexpr size_t O_H_P = O_CONV_P + NB * 3 * DR;
constexpr size_t O_DW_P = O_H_P + NB * DR;
constexpr size_t O_CONV_S = O_DW_P + NB * 30 * DC;
constexpr size_t O_H_S = O_CONV_S + SB * 3 * DR;
constexpr size_t O_DW_S = O_H_S + SB * DR;
constexpr size_t O_END = O_DW_S + SB * 30 * DC;
static_assert(O_END == 17510400, "d_out size");
constexpr size_t MiB = 1u << 20;
constexpr size_t WS_CTL = 0, CTL_ZERO_BYTES = 64 * 1024;
constexpr size_t WS_W1 = 2 * MiB, WS_WO = 6 * MiB, WS_WUP = 8 * MiB, WS_WDN = 16 * MiB;
constexpr size_t WS_WG = 24 * MiB;
constexpr size_t WS_LU = WS_WG + 256 * 1024;
constexpr size_t WS_AGG = 25 * MiB;
constexpr size_t WS_SSQ1 = 27 * MiB, WS_SSQ2 = 29 * MiB;
constexpr size_t WS_X1B = 32 * MiB;
constexpr size_t WS_HN = 66 * MiB;
constexpr size_t WS_XR = 100 * MiB, WS_GG = 117 * MiB, WS_V = 134 * MiB;
constexpr size_t WS_MIX = 151 * MiB;
constexpr size_t WS_U = 66 * MiB;
constexpr size_t WS_PL = 198 * MiB;
constexpr size_t WS_END = 232 * MiB;
static_assert(WS_AGG + 265 * 512 * 8 <= WS_SSQ1 && WS_SSQ1 + (size_t)M_MAIN * 64 <= WS_SSQ2 && WS_SSQ2 + (size_t)M_MAIN * 64 <= WS_X1B, "ws map 1");
static_assert(WS_X1B + (size_t)M_MAIN * D * 2 <= WS_HN && WS_HN + (size_t)M_Z * D * 2 <= WS_XR && WS_XR + (size_t)M_Z * 512 * 2 <= WS_GG && WS_GG + (size_t)M_Z * 512 * 2 <= WS_V && WS_V + (size_t)M_Z * 512 * 2 <= WS_MIX, "ws map 2");
static_assert(WS_MIX + (size_t)M_MAIN * D * 2 <= WS_END && WS_U + (size_t)M_MAIN * FF * 2 <= WS_END, "ws map 3");
constexpr int CW_BAR = 4096;
static_assert((CW_BAR + 3456) * 4 <= (int)CTL_ZERO_BYTES, "CTL");
constexpr int RING_BYTES = 131072;
constexpr int MISC_OFF = 159744;
constexpr int LDS_BYTES = MISC_OFF + 256;

typedef unsigned u32x2v __attribute__((ext_vector_type(2)));
typedef float f32x2v __attribute__((ext_vector_type(2)));
__device__ __forceinline__ float bf_lo(unsigned u) { return __builtin_bit_cast(float, u << 16); }
__device__ __forceinline__ float bf_hi(unsigned u) { return __builtin_bit_cast(float, u & 0xffff0000u); }
__device__ __forceinline__ float sigm(float x) { return __builtin_amdgcn_rcpf(1.0f + __builtin_amdgcn_exp2f(-1.4426950408889634f * x)); }

constexpr size_t WS_CT = WS_LU + 4096;
constexpr int CT_CW = 0, CT_CB = 4 * 512, CT_BGR = 5 * 512, CT_BGI = 6 * 512, CT_DWW = 7 * 512, CT_DWB = 38 * 512, CT_LNG = 39 * 512, CT_LNB = 40 * 512, CT_ONR = 41 * 512, CT_ONC = 42 * 512, CT_NF = 43 * 512, CT_END = 45 * 512;
static_assert(WS_CT + CT_END * 4 <= WS_AGG, "constants table");
struct Frame {
    LAS unsigned char* lds;
    int tid, lane, wave, G, bid;
    unsigned char* ws; float* out; size_t z;
    const float *x_prompt, *x_sample, *st_conv, *st_h, *st_dw;
#define WSP(name, type, off) __device__ __forceinline__ type* name() const { return (type*)(ws + (z + (off))); }
    WSP(W1t, bf16, WS_W1) WSP(Wot, bf16, WS_WO) WSP(Wupt, bf16, WS_WUP) WSP(Wdt, bf16, WS_WDN) WSP(Wg, bf16, WS_WG) WSP(HN, bf16, WS_HN) WSP(XR, bf16, WS_XR) WSP(GG, bf16, WS_GG) WSP(V, bf16, WS_V)
    WSP(MIX, bf16, WS_MIX) WSP(PL, unsigned short, WS_PL) WSP(X1B, bf16, WS_X1B) WSP(U, bf16, WS_U) WSP(LU, float, WS_LU) WSP(AGG, float, WS_AGG) WSP(SSQ1, float, WS_SSQ1) WSP(SSQ2, float, WS_SSQ2)
    WSP(cw, float, WS_CT + 4 * CT_CW) WSP(cb, float, WS_CT + 4 * CT_CB) WSP(bgr, float, WS_CT + 4 * CT_BGR) WSP(bgi, float, WS_CT + 4 * CT_BGI) WSP(dww, float, WS_CT + 4 * CT_DWW) WSP(dwb, float, WS_CT + 4 * CT_DWB)
    WSP(lng, float, WS_CT + 4 * CT_LNG) WSP(lnb, float, WS_CT + 4 * CT_LNB) WSP(onr, float, WS_CT + 4 * CT_ONR) WSP(onc, float, WS_CT + 4 * CT_ONC) WSP(norm_final, float, WS_CT + 4 * CT_NF)
#undef WSP
};

__device__ __forceinline__ float wave_sum(float v) {
#pragma unroll
    for (int o = 1; o < 64; o <<= 1) v += __shfl_xor(v, o);
    return v;
}
__device__ __forceinline__ void p0_transpose_item(const float* W, int K, int N, bf16* WT, const float* gain, LAS float* scr, int k0, int n0, int dest_row0, int lane) {
#pragma unroll 8
    for (int i = 0; i < 32; ++i) { const int kk = 2 * i + (lane >> 5); float w = W[(size_t)(k0 + kk) * N + n0 + (lane & 31)]; if (gain) w *= gain[k0 + kk]; scr[kk * 33 + (lane & 31)] = w; }
    LDS_WAIT(); asm volatile("" ::: "memory");
    const int c = lane & 7;
#pragma unroll
    for (int j = 0; j < 4; ++j) { const int n = (lane >> 3) + 8 * j; const LAS float* s = scr + (8 * c) * 33 + n;
        v4u o; o.x = pk2(s[0 * 33], s[1 * 33]); o.y = pk2(s[2 * 33], s[3 * 33]); o.z = pk2(s[4 * 33], s[5 * 33]); o.w = pk2(s[6 * 33], s[7 * 33]);
        *(GAS v4u*)(WT + (size_t)(dest_row0 + n) * K + k0 + 8 * c) = o; }
    LDS_WAIT(); asm volatile("" ::: "memory");
}
__device__ __forceinline__ int w1_dest_row(int n0) {
    if (n0 < 1024) return n0;
    if (n0 < 1536) { const int q = (n0 - 1024) >> 7, tc = (n0 - 1024) & 127; return 1024 + 256 * q + tc; }
    { const int q = (n0 - 1536) >> 7, tc = (n0 - 1536) & 127; return 1024 + 256 * q + 128 + tc; }
}
template <class ArgsT> __device__ __forceinline__ void p0_prologue(Frame& F, const ArgsT& A) {
    const float *meta = A.in[5], *norm_mix = A.in[6], *w_in = A.in[7], *wgr = A.in[10], *wgi = A.in[12], *lam = A.in[14], *w_out = A.in[21], *norm_mlp = A.in[22], *w_up = A.in[23], *w_down = A.in[24];
    LAS float* scr = (LAS float*)(F.lds + F.wave * 16384);
    const int gw = F.bid * NWAVES + F.wave, NGW = F.G * NWAVES, lane = F.lane;
    constexpr int I_1 = (D / 64) * (DIN / 32), I_O = (D / 64) * (D / 32), I_U = (D / 64) * (FF / 32), I_D = (FF / 64) * (D / 32);
    constexpr int NITEMS = I_1 + I_O + I_U + I_D;
    for (int it = gw; it < NITEMS; it += NGW) {
        int r = it;
        if (r < I_1) { const int nblk = DIN / 32, kb = r / nblk, nb = r % nblk; p0_transpose_item(w_in, D, DIN, F.W1t(), nullptr, scr, 64 * kb, 32 * nb, w1_dest_row(32 * nb), lane); continue; } r -= I_1;
        if (r < I_O) { const int nblk = D / 32, kb = r / nblk, nb = r % nblk; p0_transpose_item(w_out, D, D, F.Wot(), nullptr, scr, 64 * kb, 32 * nb, 32 * nb, lane); continue; } r -= I_O;
        if (r < I_U) { const int nblk = FF / 32, kb = r / nblk, nb = r % nblk; p0_transpose_item(w_up, D, FF, F.Wupt(), norm_mlp, scr, 64 * kb, 32 * nb, 32 * nb, lane); continue; } r -= I_U;
        { const int nblk = D / 32, kb = r / nblk, nb = r % nblk; p0_transpose_item(w_down, FF, D, F.Wdt(), nullptr, scr, 64 * kb, 32 * nb, 32 * nb, lane); }
    }
    const int gt = F.bid * (NWAVES * 64) + F.tid, NGT = F.G * NWAVES * 64;
    for (int i = gt; i < 2 * NH * HD * HD; i += NGT) { const int g = i >> 15, h = (i >> 12) & 7, e = (i >> 6) & 63, d = i & 63; const float* src = g ? wgi : wgr; F.Wg()[i] = (bf16)f2bf(src[(h * 64 + d) * 64 + e]); }
    for (int i = gt; i < DR; i += NGT) F.LU()[i] = -8.0f * log1pf(expf(-lam[i]));
    { float* ct = (float*)(F.ws + WS_CT);
      for (int i = gt; i < CT_END; i += NGT) { float v;
        if (i < CT_CB) v = A.in[8][i]; else if (i < CT_BGR) v = A.in[9][i - CT_CB]; else if (i < CT_BGI) v = A.in[11][i - CT_BGR]; else if (i < CT_DWW) v = A.in[13][i - CT_BGI];
        else if (i < CT_DWB) v = A.in[15][i - CT_DWW]; else if (i < CT_LNG) v = A.in[16][i - CT_DWB]; else if (i < CT_LNB) v = A.in[17][i - CT_LNG]; else if (i < CT_ONR) v = A.in[18][i - CT_LNB];
        else if (i < CT_ONC) v = A.in[19][i - CT_ONR]; else if (i < CT_NF) v = A.in[20][i - CT_ONC]; else v = A.in[25][i - CT_NF];
        ct[i] = v; } }
    for (int m = gw; m < M_Z; m += NGW) {
        GAS unsigned long long* o8 = (GAS unsigned long long*)(F.HN() + (size_t)m * D) + lane;
        if (m >= ROW_META + NMETA) {
#pragma unroll
            for (int j = 0; j < 4; ++j) o8[64 * j] = 0ull;
            continue; }
        const float* xrow = m < M_PROMPT ? F.x_prompt + (size_t)m * D : (m < M_MAIN ? F.x_sample + (size_t)(m - M_PROMPT) * D : meta + (size_t)(m - ROW_META) * D);
        const GAS f32x4* xr = (const GAS f32x4*)xrow + lane; const GAS f32x4* gr = (const GAS f32x4*)norm_mix + lane;
        f32x4 v[4]; float s = 0.f;
#pragma unroll
        for (int j = 0; j < 4; ++j) { v[j] = xr[64 * j]; s += (v[j].x * v[j].x + v[j].y * v[j].y) + (v[j].z * v[j].z + v[j].w * v[j].w); }
        const float rinv = 1.0f / sqrtf(wave_sum(s) * (1.f / D) + EPS);
#pragma unroll
        for (int j = 0; j < 4; ++j) { const f32x4 g = gr[64 * j]; const f32x4 y = v[j] * rinv * g; o8[64 * j] = (unsigned long long)pk2(y.x, y.y) | ((unsigned long long)pk2(y.z, y.w) << 32); }
    }
}
struct SeqUnit { int kind, b, row0, t0, ntb, j; };
__device__ __forceinline__ SeqUnit seq_unit(int id) {
    SeqUnit u;
    if (id < 256) { u.kind = 0; u.b = id >> 6; u.j = id & 63; u.row0 = u.b * SEQ; u.t0 = 64 * u.j; u.ntb = 4; }
    else if (id < 264) { u.kind = 1; u.b = id - 256; u.j = 0; u.row0 = M_PROMPT + SS * u.b; u.t0 = 0; u.ntb = 4; }
    else { u.kind = 2; u.b = 0; u.j = 0; u.row0 = ROW_META; u.t0 = 0; u.ntb = 1; }
    return u;
}
__device__ __forceinline__ float dpp_shr(float v, float ident, int sh) {
    int r;
    switch (sh) {
        case 1: r = __builtin_amdgcn_update_dpp(__builtin_bit_cast(int, ident), __builtin_bit_cast(int, v), 0x111, 0xF, 0xF, false); break;
        case 2: r = __builtin_amdgcn_update_dpp(__builtin_bit_cast(int, ident), __builtin_bit_cast(int, v), 0x112, 0xF, 0xF, false); break;
        case 4: r = __builtin_amdgcn_update_dpp(__builtin_bit_cast(int, ident), __builtin_bit_cast(int, v), 0x114, 0xF, 0xF, false); break;
        default: r = __builtin_amdgcn_update_dpp(__builtin_bit_cast(int, ident), __builtin_bit_cast(int, v), 0x118, 0xF, 0xF, false); break;
    }
    return __builtin_bit_cast(float, r);
}
typedef _Float16 h16x2 __attribute__((ext_vector_type(2)));
template <int M> __device__ __forceinline__ float shx(float v, int a32) {
    if (M < 32) return __builtin_bit_cast(float, __builtin_amdgcn_ds_swizzle(__builtin_bit_cast(int, v), (M << 10) | 0x1F));
    return __builtin_bit_cast(float, __builtin_amdgcn_ds_bpermute(a32, __builtin_bit_cast(int, v)));
}
#define RNN_SCAN_STEP(sh) asm volatile("s_nop 1\n\t" \
    "v_fmac_f32_dpp %0, %0, %4 row_shr:" #sh " row_mask:0xf bank_mask:0xf\n\t" "v_fmac_f32_dpp %1, %1, %5 row_shr:" #sh " row_mask:0xf bank_mask:0xf\n\t" \
    "v_fmac_f32_dpp %2, %2, %6 row_shr:" #sh " row_mask:0xf bank_mask:0xf\n\t" "v_fmac_f32_dpp %3, %3, %7 row_shr:" #sh " row_mask:0xf bank_mask:0xf\n\t" \
    "v_mul_f32_dpp %4, %4, %4 row_shr:" #sh " row_mask:0xf bank_mask:0xf\n\t" "v_mul_f32_dpp %5, %5, %5 row_shr:" #sh " row_mask:0xf bank_mask:0xf\n\t" \
    "v_mul_f32_dpp %6, %6, %6 row_shr:" #sh " row_mask:0xf bank_mask:0xf\n\t" "v_mul_f32_dpp %7, %7, %7 row_shr:" #sh " row_mask:0xf bank_mask:0xf" \
    : "+v"(Bv[0]), "+v"(Bv[1]), "+v"(Bv[2]), "+v"(Bv[3]), "+v"(Av[0]), "+v"(Av[1]), "+v"(Av[2]), "+v"(Av[3]))
constexpr int RNN_WL = 12544, XT_PITCH = 144, XT_ROWS = 72, CWT_OFF = XT_ROWS * XT_PITCH  , VEC_OFF = CWT_OFF + 1024;
__device__ __forceinline__ void rnn_pass1(Frame& F) {
    const int h = F.wave, lane = F.lane;
    LAS unsigned char* wl = F.lds + h * RNN_WL;
    {
        LAS float* cwt = (LAS float*)(wl + CWT_OFF); LAS float* vec = (LAS float*)(wl + VEC_OFF);
        const float* cw = F.cw();
#pragma unroll
        for (int k = 0; k < 4; ++k) cwt[k * 64 + lane] = cw[k * DR + 64 * h + lane];
        vec[lane] = F.cb()[64 * h + lane]; vec[64 + lane] = F.bgr()[64 * h + lane]; vec[128 + lane] = F.bgi()[64 * h + lane]; vec[192 + lane] = 1.4426950408889634f * F.LU()[64 * h + lane];
    }
    int fr = lane & 15, fq = lane >> 4;
    const int b15 = ((lane & 48) | 15) << 2;
    bf16x8 Wr[4][2], Wi[4][2];
#pragma unroll
    for (int eb = 0; eb < 4; ++eb)
#pragma unroll
        for (int ks = 0; ks < 2; ++ks) { const bf16* wp = F.Wg() + ((size_t)h * HD + 16 * eb + fr) * HD + 32 * ks + 8 * fq; Wr[eb][ks] = *(const bf16x8*)wp; Wi[eb][ks] = *(const bf16x8*)(wp + NH * HD * HD); }
    bf16x8 Id[2];
#pragma unroll
    for (int o = 0; o < 2; ++o) { const int j = 16 * o + fr - 8 * fq; v4u w = {0u, 0u, 0u, 0u};
        if (j >= 0 && j < 8) { const unsigned one = 0x3F80u << (16 * (j & 1)); if ((j >> 1) == 0) w.x = one; else if ((j >> 1) == 1) w.y = one; else if ((j >> 1) == 2) w.z = one; else w.w = one; }
        Id[o] = __builtin_bit_cast(bf16x8, w); }
#pragma unroll 1
    for (int uid = F.G - 1 - F.bid; uid < 265; uid += F.G) {
        const SeqUnit u = seq_unit(uid);
        asm volatile("" : "+v"(fr), "+v"(fq));
        {   v4u val[9];
#pragma unroll
            for (int i = 0; i < 9; ++i) { const int row = 8 * i + (lane >> 3), sv = u.t0 - 3 + row;
                const bool ok = (sv >= 0 && row < 3 + 16 * u.ntb) || (sv < 0 && u.kind == 0);
                const size_t grow = sv >= 0 ? (size_t)(u.row0 + sv) : (size_t)(ROW_META + NMETA + sv);
                val[i] = *(const v4u*)(F.XR() + (ok ? grow : 0) * ZCOLS + 64 * h + 8 * (lane & 7));
                if (!ok) val[i] = (v4u){0u, 0u, 0u, 0u}; }
#pragma unroll
            for (int i = 0; i < 9; ++i) *(LAS v4u*)(wl + (8 * i + (lane >> 3)) * XT_PITCH + 16 * (lane & 7)) = val[i];
            if (u.kind == 1 && lane < 24) {
                const int row = lane >> 3; const float* p = F.st_conv + (size_t)(u.b * 3 + row) * DR + 64 * h + 8 * (lane & 7); const f32x4 a = *(const f32x4*)p, b = *(const f32x4*)(p + 4);
                v4u w; w.x = pk2(a.x, a.y); w.y = pk2(a.z, a.w); w.z = pk2(b.x, b.y); w.w = pk2(b.z, b.w); *(LAS v4u*)(wl + row * XT_PITCH + 16 * (lane & 7)) = w; }
        }
        float H[4][4], Pc[4][4];
#pragma unroll
        for (int eb = 0; eb < 4; ++eb)
#pragma unroll
            for (int r = 0; r < 4; ++r) { H[eb][r] = 0.f; Pc[eb][r] = 1.f; }
        const LAS float* cwt = (const LAS float*)(wl + CWT_OFF); const LAS float* vec = (const LAS float*)(wl + VEC_OFF);
#pragma unroll 1
        for (int tb = 0; tb < u.ntb; ++tb) {
            const int s = u.t0 + 16 * tb + fr;
            u32x2v ggw[4];
#pragma unroll
            for (int eb = 0; eb < 4; ++eb) ggw[eb] = *(const u32x2v*)(F.GG() + (size_t)(u.row0 + s) * ZCOLS + 64 * h + 16 * eb + 4 * fq);
            bf16x8 Xf[2];
#pragma unroll
            for (int ks = 0; ks < 2; ++ks) {
                const int cl = 32 * ks + 8 * fq; float a8[8];
                { const f32x4 b0 = *(const LAS f32x4*)(vec + cl), b1 = *(const LAS f32x4*)(vec + cl + 4); a8[0] = b0.x; a8[1] = b0.y; a8[2] = b0.z; a8[3] = b0.w; a8[4] = b1.x; a8[5] = b1.y; a8[6] = b1.z; a8[7] = b1.w; }
#pragma unroll
                for (int k = 0; k < 4; ++k) { const v4u xw = *(const LAS v4u*)(wl + (16 * tb + fr + k) * XT_PITCH + 2 * cl); const f32x4 w0 = *(const LAS f32x4*)(cwt + k * 64 + cl), w1 = *(const LAS f32x4*)(cwt + k * 64 + cl + 4);
                    a8[0] += w0.x * bf_lo(xw.x); a8[1] += w0.y * bf_hi(xw.x); a8[2] += w0.z * bf_lo(xw.y); a8[3] += w0.w * bf_hi(xw.y); a8[4] += w1.x * bf_lo(xw.z); a8[5] += w1.y * bf_hi(xw.z); a8[6] += w1.z * bf_lo(xw.w); a8[7] += w1.w * bf_hi(xw.w); }
                v4u pk; pk.x = pg8::cvt_pk_bf16(a8[0], a8[1]); pk.y = pg8::cvt_pk_bf16(a8[2], a8[3]); pk.z = pg8::cvt_pk_bf16(a8[4], a8[5]); pk.w = pg8::cvt_pk_bf16(a8[6], a8[7]);
                Xf[ks] = __builtin_bit_cast(bf16x8, pk);
                asm volatile("" ::: "memory");
            }
#pragma unroll
            for (int eb = 0; eb < 4; ++eb) {
                asm volatile("" ::: "memory");
                f32x4 ar = {0.f, 0.f, 0.f, 0.f}, ai = {0.f, 0.f, 0.f, 0.f}, xc = {0.f, 0.f, 0.f, 0.f};
                ar = __builtin_amdgcn_mfma_f32_16x16x32_bf16(Wr[eb][0], Xf[0], ar, 0, 0, 0); ar = __builtin_amdgcn_mfma_f32_16x16x32_bf16(Wr[eb][1], Xf[1], ar, 0, 0, 0);
                ai = __builtin_amdgcn_mfma_f32_16x16x32_bf16(Wi[eb][0], Xf[0], ai, 0, 0, 0); ai = __builtin_amdgcn_mfma_f32_16x16x32_bf16(Wi[eb][1], Xf[1], ai, 0, 0, 0);
                xc = __builtin_amdgcn_mfma_f32_16x16x32_bf16(Id[eb & 1], Xf[eb >> 1], xc, 0, 0, 0);
                const int cl = 16 * eb + 4 * fq;
                const f32x4 br = *(const LAS f32x4*)(vec + 64 + cl), bi = *(const LAS f32x4*)(vec + 128 + cl), lu = *(const LAS f32x4*)(vec + 192 + cl);
                const float gg[4] = {bf_lo(ggw[eb].x), bf_hi(ggw[eb].x), bf_lo(ggw[eb].y), bf_hi(ggw[eb].y)};
                float Av[4], Bv[4];
#pragma unroll
                for (int r = 0; r < 4; ++r) {
                    const float rg = sigm(ar[r] + br[r]), ig = sigm(ai[r] + bi[r]);
                    Av[r] = __builtin_amdgcn_exp2f(rg * lu[r]);
                    Bv[r] = __builtin_amdgcn_sqrtf(fmaxf(1.0f - Av[r] * Av[r], 0.f)) * ig * xc[r];
                }
                RNN_SCAN_STEP(1); RNN_SCAN_STEP(2); RNN_SCAN_STEP(4); RNN_SCAN_STEP(8);
                v4u pl;
#pragma unroll
                for (int r = 0; r < 4; ++r) {
                    const float lh = Av[r] * H[eb][r] + Bv[r], pt = Av[r] * Pc[eb][r];
                    H[eb][r] = __builtin_bit_cast(float, __builtin_amdgcn_ds_bpermute(b15, __builtin_bit_cast(int, lh)));
                    Pc[eb][r] = __builtin_bit_cast(float, __builtin_amdgcn_ds_bpermute(b15, __builtin_bit_cast(int, pt)));
                    pl[r] = __builtin_bit_cast(unsigned, __builtin_amdgcn_cvt_pkrtz(pt * gg[r], lh * gg[r]));
                }
                if (u.kind != 2) *(v4u*)(F.PL() + ((size_t)(u.row0 + s) * DR + 64 * h + cl) * 2) = pl;
            }
        }
        if (fr == 0) {
#pragma unroll
            for (int eb = 0; eb < 4; ++eb) { float* p = F.AGG() + ((size_t)uid * DR + 64 * h + 16 * eb + 4 * fq) * 2;
                *(f32x4*)p = (f32x4){Pc[eb][0], H[eb][0], Pc[eb][1], H[eb][1]}; *(f32x4*)(p + 4) = (f32x4){Pc[eb][2], H[eb][2], Pc[eb][3], H[eb][3]}; }
        }
    }
}
__device__ __forceinline__ void rnn_pass2(Frame& F, int uid) {
    const SeqUnit u = seq_unit(uid);
    const int h = F.wave, lane = F.lane; int fr = lane & 15, fq = lane >> 4;
    asm volatile("" : "+v"(fr), "+v"(fq));
    float Hin[4][4];
    if (u.kind == 1) {
#pragma unroll
        for (int eb = 0; eb < 4; ++eb) { const f32x4 v = *(const f32x4*)(F.st_h + (size_t)u.b * DR + 64 * h + 16 * eb + 4 * fq); Hin[eb][0] = v.x; Hin[eb][1] = v.y; Hin[eb][2] = v.z; Hin[eb][3] = v.w; }
    } else {
        const int n = u.j + 1;
#pragma unroll
        for (int eb = 0; eb < 4; ++eb) {
            f32x4 q0[4], q1[4];
#pragma unroll
            for (int i = 0; i < 4; ++i) { const int idx = 4 * fr + i; const int au = idx == 0 ? 264 : u.b * 64 + idx - 1;
                const float* p = F.AGG() + ((size_t)(idx < n ? au : 264) * DR + 64 * h + 16 * eb + 4 * fq) * 2; q0[i] = *(const f32x4*)p; q1[i] = *(const f32x4*)(p + 4); }
            float A[4] = {1.f, 1.f, 1.f, 1.f}, B[4] = {0.f, 0.f, 0.f, 0.f};
#pragma unroll
            for (int i = 0; i < 4; ++i) { const bool ok = 4 * fr + i < n;
                const float a0 = ok ? q0[i].x : 1.f, b0 = ok ? q0[i].y : 0.f, a1 = ok ? q0[i].z : 1.f, b1 = ok ? q0[i].w : 0.f, a2 = ok ? q1[i].x : 1.f, b2 = ok ? q1[i].y : 0.f, a3 = ok ? q1[i].z : 1.f, b3 = ok ? q1[i].w : 0.f;
                B[0] = a0 * B[0] + b0; A[0] *= a0; B[1] = a1 * B[1] + b1; A[1] *= a1; B[2] = a2 * B[2] + b2; A[2] *= a2; B[3] = a3 * B[3] + b3; A[3] *= a3; }
#pragma unroll
            for (int r = 0; r < 4; ++r) {
#pragma unroll
                for (int sh = 1; sh < 16; sh <<= 1) { const float Ap = dpp_shr(A[r], 1.0f, sh), Bp = dpp_shr(B[r], 0.0f, sh); B[r] = A[r] * Bp + B[r]; A[r] = A[r] * Ap; }
                Hin[eb][r] = __shfl(B[r], (lane & 48) | 15);
            }
        }
    }
    float yv[4][4][4]; LAS float* red = (LAS float*)F.lds;
#pragma unroll
    for (int tb = 0; tb < 4; ++tb) {
        const int s = u.t0 + 16 * tb + fr; float ssq = 0.f;
#pragma unroll
        for (int eb = 0; eb < 4; ++eb) { const v4u pl = *(const v4u*)(F.PL() + ((size_t)(u.row0 + s) * DR + 64 * h + 16 * eb + 4 * fq) * 2);
#pragma unroll
            for (int r = 0; r < 4; ++r) { const unsigned plw = pl[r]; const h16x2 hv = __builtin_bit_cast(h16x2, plw);     const float y = (float)hv.x * Hin[eb][r] + (float)hv.y; yv[tb][eb][r] = y; ssq += y * y; } }
        ssq += __shfl_xor(ssq, 16); ssq += __shfl_xor(ssq, 32); if (fq == 0) red[(16 * tb + fr) * 8 + h] = ssq;
    }
    __syncthreads();
#pragma unroll
    for (int tb = 0; tb < 4; ++tb) {
        const LAS f32x4* rp = (const LAS f32x4*)(red + (16 * tb + fr) * 8); const f32x4 a = rp[0], b = rp[1];
        const float rinv = 1.0f / sqrtf(((a.x + a.y) + (a.z + a.w) + (b.x + b.y) + (b.z + b.w)) * (1.0f / DR) + EPS);
        bf16* orow = F.MIX() + (size_t)(u.row0 + u.t0 + 16 * tb + fr) * D + 64 * h + 4 * fq;
#pragma unroll
        for (int eb = 0; eb < 4; ++eb) { const f32x4 g = *(const f32x4*)(F.onr() + 64 * h + 16 * eb + 4 * fq);
            u32x2v w; w.x = pk2(yv[tb][eb][0] * rinv * g.x, yv[tb][eb][1] * rinv * g.y); w.y = pk2(yv[tb][eb][2] * rinv * g.z, yv[tb][eb][3] * rinv * g.w); *(u32x2v*)(orow + 16 * eb) = w; }
    }
    if (fr == 0 && (u.kind == 1 || u.j == 63)) {
        float* ho = F.out + (u.kind == 1 ? O_H_S : O_H_P) + (size_t)u.b * DR;
#pragma unroll
        for (int eb = 0; eb < 4; ++eb) { const float* p = F.AGG() + ((size_t)uid * DR + 64 * h + 16 * eb + 4 * fq) * 2; const f32x4 a = *(const f32x4*)p, b = *(const f32x4*)(p + 4);
            *(f32x4*)(ho + 64 * h + 16 * eb + 4 * fq) = (f32x4){a.x * Hin[eb][0] + a.y, a.z * Hin[eb][1] + a.w, b.x * Hin[eb][2] + b.y, b.z * Hin[eb][3] + b.w}; }
    }
    __syncthreads();
}
template <int N> __device__ __forceinline__ float xreduce(float (&v)[N], int lane) {
    const int a32 = (lane ^ 32) << 2;
    {   const bool up = (lane & 32) != 0;
#pragma unroll
        for (int i = 0; i < N / 2; ++i) { const float send = up ? v[i] : v[i + N / 2], keep = up ? v[i + N / 2] : v[i]; v[i] = keep + shx<32>(send, a32); } }
    if (N >= 4) { const bool up = (lane & 16) != 0;
#pragma unroll
        for (int i = 0; i < N / 4; ++i) { const float send = up ? v[i] : v[i + N / 4], keep = up ? v[i + N / 4] : v[i]; v[i] = keep + shx<16>(send, a32); } }
    if (N >= 8) { const bool up = (lane & 8) != 0;
#pragma unroll
        for (int i = 0; i < N / 8; ++i) { const float send = up ? v[i] : v[i + N / 8], keep = up ? v[i + N / 8] : v[i]; v[i] = keep + shx<8>(send, a32); } }
    if (N >= 16) { const bool up = (lane & 4) != 0; const float send = up ? v[0] : v[1], keep = up ? v[1] : v[0]; v[0] = keep + shx<4>(send, a32); }
    float r = v[0];
    if (N < 16) r += shx<4>(r, a32);
    if (N < 8) r += shx<8>(r, a32);
    r += shx<2>(r, a32); r += shx<1>(r, a32);
    return r;
}
constexpr int CV_W_OFF = 0, CV_V_OFF = 31 * 2048  , CV_END = CV_V_OFF + 94 * 1024  ;
__device__ __forceinline__ void conv_fill_weights(Frame& F) {
    const float* w = F.dww();
    for (int i = F.tid; i < 31 * 128; i += NWAVES * 64) { const int k = i >> 7, g = i & 127;
        *(LAS f32x4*)(F.lds + CV_W_OFF + k * 2048 + (g & 1) * 1024 + (g >> 1) * 16) = *(const f32x4*)(w + k * DC + 4 * g); }
}
__device__ __forceinline__ void conv_unit(Frame& F, int uid) {
    const SeqUnit u = seq_unit(uid);
    const int lane = F.lane, wv = F.wave;
    LAS unsigned char* vt = F.lds + CV_V_OFF;
    __syncthreads();
    {   v4u val[12];
#pragma unroll
        for (int i = 0; i < 12; ++i) { const int r = wv + NWAVES * i, sv = u.t0 - 30 + r;
            const bool ok = r < 94 && (sv >= 0 || (u.kind == 0 && NMETA + sv >= 0));
            const size_t grow = sv >= 0 ? (size_t)(u.row0 + sv) : (size_t)(ROW_META + NMETA + sv);
            val[i] = *(const v4u*)(F.V() + (ok ? grow : 0) * ZCOLS + 8 * lane);
            if (!ok) val[i] = (v4u){0u, 0u, 0u, 0u}; }
#pragma unroll
        for (int i = 0; i < 12; ++i) { const int r = wv + NWAVES * i; if (r < 94) *(LAS v4u*)(vt + r * 1024 + 16 * lane) = val[i]; }
        if (u.kind == 1) {
#pragma unroll
            for (int i = 0; i < 4; ++i) { const int r = wv + NWAVES * i;
                if (r < 30) { const float* p = F.st_dw + (size_t)(u.b * 30 + r) * DC + 8 * lane; const f32x4 a = *(const f32x4*)p, b = *(const f32x4*)(p + 4);
                    v4u w; w.x = pk2(a.x, a.y); w.y = pk2(a.z, a.w); w.z = pk2(b.x, b.y); w.w = pk2(b.z, b.w); *(LAS v4u*)(vt + r * 1024 + 16 * lane) = w; } }
        }
    }
    unsigned cb = (unsigned)lane * 32u; asm volatile("" : "+v"(cb));
    float acc[8][8];
    { const f32x4 b0 = *(const f32x4*)((const char*)F.dwb() + cb), b1 = *(const f32x4*)((const char*)F.dwb() + cb + 16);
#pragma unroll
      for (int j = 0; j < 8; ++j) { acc[j][0] = b0.x; acc[j][1] = b0.y; acc[j][2] = b0.z; acc[j][3] = b0.w; acc[j][4] = b1.x; acc[j][5] = b1.y; acc[j][6] = b1.z; acc[j][7] = b1.w; } }
    __syncthreads();
    {   const LAS unsigned char* xp = vt + (8 * wv) * 1024 + (cb >> 1);
        const LAS unsigned char* wp = F.lds + CV_W_OFF + (cb >> 1);
        f32x4 wl[31], wh[31];
#pragma unroll
        for (int i = 0; i < 38; ++i) {
            if (i < 31) { wl[i] = *(const LAS f32x4*)(wp + i * 2048); wh[i] = *(const LAS f32x4*)(wp + i * 2048 + 1024); }
            const v4u xw = *(const LAS v4u*)(xp + i * 1024);
            const float x[8] = {bf_lo(xw.x), bf_hi(xw.x), bf_lo(xw.y), bf_hi(xw.y), bf_lo(xw.z), bf_hi(xw.z), bf_lo(xw.w), bf_hi(xw.w)};
#pragma unroll
            for (int j = 0; j < 8; ++j) { const int k = i - j;
                if (k >= 0 && k < 31) { acc[j][0] += wl[k].x * x[0]; acc[j][1] += wl[k].y * x[1]; acc[j][2] += wl[k].z * x[2]; acc[j][3] += wl[k].w * x[3];
                                        acc[j][4] += wh[k].x * x[4]; acc[j][5] += wh[k].y * x[5]; acc[j][6] += wh[k].z * x[6]; acc[j][7] += wh[k].w * x[7]; } }
#pragma unroll
            for (int j = 0; j < 8; ++j) asm volatile("" : "+v"(acc[j][0]), "+v"(acc[j][1]), "+v"(acc[j][2]), "+v"(acc[j][3]), "+v"(acc[j][4]), "+v"(acc[j][5]), "+v"(acc[j][6]), "+v"(acc[j][7]) :: "memory");
        }
    }
    float st[16];
#pragma unroll
    for (int j = 0; j < 8; ++j) { float s1 = 0.f, s2 = 0.f;
#pragma unroll
        for (int c = 0; c < 8; ++c) { s1 += acc[j][c]; s2 += acc[j][c] * acc[j][c]; }
        st[j] = s1; st[8 + j] = s2; }
    const float tot = xreduce<16>(st, lane);
    float lg[8], lb[8];
    { const f32x4 a0 = *(const f32x4*)((const char*)F.lng() + cb), a1 = *(const f32x4*)((const char*)F.lng() + cb + 16), c0 = *(const f32x4*)((const char*)F.lnb() + cb), c1 = *(const f32x4*)((const char*)F.lnb() + cb + 16);
      lg[0] = a0.x; lg[1] = a0.y; lg[2] = a0.z; lg[3] = a0.w; lg[4] = a1.x; lg[5] = a1.y; lg[6] = a1.z; lg[7] = a1.w; lb[0] = c0.x; lb[1] = c0.y; lb[2] = c0.z; lb[3] = c0.w; lb[4] = c1.x; lb[5] = c1.y; lb[6] = c1.z; lb[7] = c1.w; }
    float q[8];
#pragma unroll
    for (int j = 0; j < 8; ++j) {
        const float S1 = __builtin_bit_cast(float, __builtin_amdgcn_readlane(__builtin_bit_cast(int, tot), 4 * j)), S2 = __builtin_bit_cast(float, __builtin_amdgcn_readlane(__builtin_bit_cast(int, tot), 4 * (8 + j)));
        const float mean = S1 * (1.0f / DC), rstd = __builtin_amdgcn_rsqf(fmaxf(S2 * (1.0f / DC) - mean * mean, 0.f) + EPS);
        float qq = 0.f;
#pragma unroll
        for (int c = 0; c < 8; ++c) { float y = (acc[j][c] - mean) * rstd * lg[c] + lb[c]; y *= sigm(y); acc[j][c] = y; qq += y * y; }
        q[j] = qq; }
    const float tot2 = xreduce<8>(q, lane);
    float og[8];
    { const f32x4 a0 = *(const f32x4*)((const char*)F.onc() + cb), a1 = *(const f32x4*)((const char*)F.onc() + cb + 16); og[0] = a0.x; og[1] = a0.y; og[2] = a0.z; og[3] = a0.w; og[4] = a1.x; og[5] = a1.y; og[6] = a1.z; og[7] = a1.w; }
#pragma unroll
    for (int j = 0; j < 8; ++j) {
        const float S = __builtin_bit_cast(float, __builtin_amdgcn_readlane(__builtin_bit_cast(int, tot2), 8 * j));
        const float rinv = __builtin_amdgcn_rsqf(S * (1.0f / DC) + EPS);
        v4u w; w.x = pg8::cvt_pk_bf16(acc[j][0] * rinv * og[0], acc[j][1] * rinv * og[1]); w.y = pg8::cvt_pk_bf16(acc[j][2] * rinv * og[2], acc[j][3] * rinv * og[3]);
        w.z = pg8::cvt_pk_bf16(acc[j][4] * rinv * og[4], acc[j][5] * rinv * og[5]); w.w = pg8::cvt_pk_bf16(acc[j][6] * rinv * og[6], acc[j][7] * rinv * og[7]);
        *(v4u*)((char*)(F.MIX() + (size_t)(u.row0 + u.t0 + 8 * wv + j) * D + DR) + (cb >> 1)) = w; }
}
__device__ __forceinline__ void state_copy(Frame& F) {
    const int gt = F.bid * (NWAVES * 64) + F.tid, NGT = F.G * NWAVES * 64;
    constexpr int NC = (NB + SB) * 3 * DR, NDW = (NB + SB) * 30 * DC;
    for (int i = gt; i < NC + NDW; i += NGT) {
        if (i < NC) { const int c = i & 511, j = (i >> 9) % 3, sq = (i >> 9) / 3;
            if (sq < NB) F.out[O_CONV_P + (size_t)(sq * 3 + j) * DR + c] = bf_lo(F.XR()[(size_t)(sq * SEQ + SEQ - 3 + j) * ZCOLS + c]);
            else { const int b = sq - NB; F.out[O_CONV_S + (size_t)(b * 3 + j) * DR + c] = bf_lo(F.XR()[(size_t)(M_PROMPT + b * SS + SS - 3 + j) * ZCOLS + c]); }
        } else { const int i2 = i - NC, c = i2 & 511, j = (i2 >> 9) % 30, sq = (i2 >> 9) / 30;
            if (sq < NB) F.out[O_DW_P + (size_t)(sq * 30 + j) * DC + c] = bf_lo(F.V()[(size_t)(sq * SEQ + SEQ - 30 + j) * ZCOLS + c]);
            else { const int b = sq - NB; F.out[O_DW_S + (size_t)(b * 30 + j) * DC + c] = bf_lo(F.V()[(size_t)(M_PROMPT + b * SS + SS - 30 + j) * ZCOLS + c]); }
        }
    }
}
template <int MT, int NT, int KW  , int MODE>
__device__ __forceinline__ void rgemm_tile(Frame& F, const bf16* A, const bf16* Bt, int row0, int b0, int bhalf, int ctile) {
    constexpr int K = KW * 8, NF = MT * NT;
    const int lane = F.lane, wv = F.wave; int fr = lane & 15, fq = lane >> 4;
    asm volatile("" : "+v"(fr), "+v"(fq));
    f32x4 acc[MT][NT];
#pragma unroll
    for (int m = 0; m < MT; ++m)
#pragma unroll
        for (int n = 0; n < NT; ++n) acc[m][n] = (f32x4){0.f, 0.f, 0.f, 0.f};
    const unsigned koff = (unsigned)(wv * KW + 8 * fq);
    unsigned aoff[MT], boff[NT];
#pragma unroll
    for (int m = 0; m < MT; ++m) aoff[m] = ((unsigned)(row0 + 16 * m + fr) * (unsigned)K + koff) * 2u;
#pragma unroll
    for (int n = 0; n < NT; ++n) boff[n] = ((unsigned)(b0 + 16 * (n % (NT / 2)) + (n / (NT / 2)) * bhalf + fr) * (unsigned)K + koff) * 2u;
#pragma unroll 4
    for (int kk = 0; kk < KW; kk += 32) {
        bf16x8 a[MT], b[NT];
#pragma unroll
        for (int m = 0; m < MT; ++m) a[m] = *(const bf16x8*)((const char*)A + aoff[m] + kk * 2);
#pragma unroll
        for (int n = 0; n < NT; ++n) b[n] = *(const bf16x8*)((const char*)Bt + boff[n] + kk * 2);
#pragma unroll
        for (int m = 0; m < MT; ++m)
#pragma unroll
            for (int n = 0; n < NT; ++n) acc[m][n] = __builtin_amdgcn_mfma_f32_16x16x32_bf16(b[n], a[m], acc[m][n], 0, 0, 0);
    }
    LAS f32x4* red = (LAS f32x4*)F.lds;
#pragma unroll
    for (int m = 0; m < MT; ++m)
#pragma unroll
        for (int n = 0; n < NT; ++n) red[(wv * NF + m * NT + n) * 64 + lane] = acc[m][n];
    __syncthreads();
    const int r = F.tid >> 4, q0 = F.tid & 15;
    static_assert(MT == 2, "thread -> row mapping assumes a 32-row tile");
    const int m = r >> 4, lrow = r & 15; const size_t R = (size_t)row0 + r;
    float ss = 0.f;
#pragma unroll
    for (int i = 0; i < NT / 4; ++i) {
        const int q = q0 + 16 * i, n = q >> 2, ln = lrow + 16 * (q & 3);
        if (MODE == 0 && bhalf != 16 * (NT / 2) && n >= NT / 2) continue;
        f32x4 v = {0.f, 0.f, 0.f, 0.f}, g = {0.f, 0.f, 0.f, 0.f};
#pragma unroll
        for (int w = 0; w < 8; ++w) v += red[(w * NF + m * NT + n) * 64 + ln];
        if (MODE == 0) {
            const bool glu = bhalf != 16 * (NT / 2);
            if (glu) {
#pragma unroll
                for (int w = 0; w < 8; ++w) g += red[(w * NF + m * NT + n + NT / 2) * 64 + ln];
#pragma unroll
                for (int j = 0; j < 4; ++j) v[j] *= sigm(g[j]);
                u32x2v w2; w2.x = pk2(v[0], v[1]); w2.y = pk2(v[2], v[3]); *(u32x2v*)(F.V() + R * ZCOLS + 32 * (ctile - 16) + 4 * q) = w2;
            } else {
                bf16* dst = ctile < 8 ? F.XR() + R * ZCOLS + 64 * ctile : F.GG() + R * ZCOLS + 64 * (ctile - 8);
                if (ctile >= 8) {
#pragma unroll
                    for (int j = 0; j < 4; ++j) v[j] = pg8::gelu_tanh(v[j]); }
                u32x2v w2; w2.x = pk2(v[0], v[1]); w2.y = pk2(v[2], v[3]); *(u32x2v*)(dst + 4 * q) = w2;
            }
        } else if (MODE == 1 || MODE == 3) {
            const int col = 16 * NT * ctile + 4 * q;
            const float* xin = MODE == 1 ? F.x_sample + (R - M_PROMPT) * D + col : F.out + R * D + col;
            const f32x4 o = *(const f32x4*)xin + v;
            *(f32x4*)(F.out + R * D + col) = o; ss += (o[0] * o[0] + o[1] * o[1]) + (o[2] * o[2] + o[3] * o[3]);
            if (MODE == 1) { u32x2v w2; w2.x = pk2(o[0], o[1]); w2.y = pk2(o[2], o[3]); *(u32x2v*)(F.X1B() + R * D + col) = w2; }
        } else {
            const float* sp = F.SSQ1() + R * 16; const f32x4 p0 = *(const f32x4*)sp, p1 = *(const f32x4*)(sp + 4), p2 = *(const f32x4*)(sp + 8), p3 = *(const f32x4*)(sp + 12);
            const f32x4 ps = (p0 + p1) + (p2 + p3); const float rinv = 1.0f / sqrtf(((ps[0] + ps[1]) + (ps[2] + ps[3])) * (1.0f / D) + EPS);
#pragma unroll
            for (int j = 0; j < 4; ++j) { const float t = fmaxf(v[j] * rinv, 0.f); v[j] = t * t; }
            u32x2v w2; w2.x = pk2(v[0], v[1]); w2.y = pk2(v[2], v[3]); *(u32x2v*)(F.U() + R * FF + 16 * NT * ctile + 4 * q) = w2;
        }
    }
    if (MODE == 1 || MODE == 3) {
        ss += __shfl_xor(ss, 1); ss += __shfl_xor(ss, 2); ss += __shfl_xor(ss, 4); ss += __shfl_xor(ss, 8);
        if (q0 == 0) (MODE == 1 ? F.SSQ1() : F.SSQ2())[R * 16 + ctile] = ss;
    }
    __syncthreads();
}
__device__ __forceinline__ void final_norm(Frame& F) {
    const int gw = F.bid * NWAVES + F.wave, NGW = F.G * NWAVES, lane = F.lane;
    for (int m = gw; m < M_MAIN; m += NGW) {
        const float p = lane < 16 ? F.SSQ2()[(size_t)m * 16 + lane] : 0.f;
        const float rinv = 1.0f / sqrtf(wave_sum(p) * (1.0f / D) + EPS);
        GAS f32x4* xr = (GAS f32x4*)(F.out + (size_t)m * D) + lane; const GAS f32x4* gr = (const GAS f32x4*)F.norm_final() + lane;
        f32x4 v[4];
#pragma unroll
        for (int j = 0; j < 4; ++j) v[j] = xr[64 * j];
#pragma unroll
        for (int j = 0; j < 4; ++j) xr[64 * j] = v[j] * rinv * gr[64 * j];
    }
}
struct Args { const float* in[26]; float* out; unsigned char* ws; };
__global__ void __launch_bounds__(NWAVES * 64, 2) hymba_fwd(Args args) {
    __shared__ __attribute__((aligned(16))) unsigned char lds_raw[LDS_BYTES];
    Frame F;
    F.lds = (LAS unsigned char*)lds_raw;
    F.tid = threadIdx.x; F.lane = F.tid & 63; F.wave = __builtin_amdgcn_readfirstlane(F.tid >> 6); F.G = gridDim.x; F.bid = blockIdx.x;
    unsigned char* ws = args.ws; F.ws = ws; F.out = args.out; F.z = 0;
    F.x_prompt = args.in[0]; F.x_sample = args.in[1]; F.st_conv = args.in[2]; F.st_h = args.in[3]; F.st_dw = args.in[4];
    volatile LAS unsigned* MISC = (volatile LAS unsigned*)(F.lds + MISC_OFF);
    if (F.tid < 64) MISC[F.tid] = 0u;
    __syncthreads();
    XcdBarrier bar = xcd_barrier_post((unsigned*)(ws + WS_CTL) + CW_BAR, MISC + 8);
#ifndef PHMASK
#define PHMASK 0xFF
#endif
#ifndef DUP_MASK
#define DUP_MASK 0
#endif
#define IN(k) ((PHMASK >> (k)) & 1)
#define REP(k) for (int rep_ = 0; rep_ < 1 + ((DUP_MASK >> (k)) & 1); ++rep_)
#define PHASE_BEGIN() do { F.z = 0; asm volatile("" : "+s"(F.z), "+v"(F.tid), "+v"(F.lane)); } while (0)
#define SEAM(k) do { if (IN(k) && IN((k) + 1)) xcd_barrier(bar); } while (0)
    if (IN(0)) REP(0) { PHASE_BEGIN(); p0_prologue(F, args); } SEAM(0);
    if (IN(1)) REP(1) { PHASE_BEGIN(); pg8::Gemm g{F.HN(), F.W1t(), M_PROMPT, DIN, D}; pg8::StaticOrder S; S.init(M_PROMPT, DIN, F.G, F.bid); pg8::EpiZ E{F.XR(), F.GG(), F.V()};
        pg8::gemm_phase<pg8::EpiZ, pg8::StaticOrder, true, true>(F.lds, g, S, E);
#pragma unroll 1
        for (int t = F.bid; t < 17 * 32; t += F.G) { const int rt = t >> 5, ct = t & 31; int b0, bhalf = 32;
            if (ct < 16) b0 = 64 * ct; else { const int vt = ct - 16; b0 = 1024 + 256 * (vt >> 2) + 32 * (vt & 3); bhalf = 128; }
            rgemm_tile<2, 4, D / 8, 0>(F, F.HN(), F.W1t(), M_PROMPT + 32 * rt, b0, bhalf, ct); }
    } SEAM(1);
    if (IN(2)) REP(2) { PHASE_BEGIN();
        __syncthreads();
#ifndef SKIP_RNN1
        for (int q_ = 0; q_ < 1 + ((DUP_MASK >> 8) & 1); ++q_) { rnn_pass1(F); __syncthreads(); }
#endif
#ifndef SKIP_CONV
        for (int q_ = 0; q_ < 1 + ((DUP_MASK >> 9) & 1); ++q_) { __syncthreads(); conv_fill_weights(F); for (int uu = F.bid; uu < 264; uu += F.G) conv_unit(F, uu); }
#endif
        for (int q_ = 0; q_ < 1 + ((DUP_MASK >> 10) & 1); ++q_) state_copy(F); } SEAM(2);
    if (IN(3)) REP(3) { PHASE_BEGIN(); for (int uu = F.bid; uu < 264; uu += F.G) rnn_pass2(F, uu); } SEAM(3);
    if (IN(4)) REP(4) { PHASE_BEGIN(); pg8::Gemm g{F.MIX(), F.Wot(), M_PROMPT, D, D}; pg8::StaticOrder S; S.init(M_PROMPT, D, F.G, F.bid); pg8::EpiRes<true> E{F.x_prompt, F.x_sample, M_PROMPT / 256, F.out, F.X1B(), F.SSQ1()};
        pg8::gemm_phase<pg8::EpiRes<true>, pg8::StaticOrder, true, true>(F.lds, g, S, E);
#pragma unroll 1
        for (int t = F.bid; t < 16 * 16; t += F.G) rgemm_tile<2, 4, D / 8, 1>(F, F.MIX(), F.Wot(), M_PROMPT + 32 * (t >> 4), 64 * (t & 15), 32, t & 15);
    } SEAM(4);
    if (IN(5)) REP(5) { PHASE_BEGIN(); pg8::Gemm g{F.X1B(), F.Wupt(), M_PROMPT, FF, D}; pg8::StaticOrder S; S.init(M_PROMPT, FF, F.G, F.bid); pg8::EpiU E{F.SSQ1(), F.U(), FF};
        pg8::gemm_phase<pg8::EpiU, pg8::StaticOrder, true, true>(F.lds, g, S, E);
#pragma unroll 1
        for (int t = F.bid; t < 16 * 32; t += F.G) rgemm_tile<2, 8, D / 8, 2>(F, F.X1B(), F.Wupt(), M_PROMPT + 32 * (t >> 5), 128 * (t & 31), 64, t & 31);
    } SEAM(5);
    if (IN(6)) { PHASE_BEGIN(); pg8::Gemm g{F.U(), F.Wdt(), M_PROMPT, D, FF}; pg8::StaticOrder S; S.init(M_PROMPT, D, F.G, F.bid); pg8::EpiRes<false> E{F.out, F.out, 1 << 20, F.out, nullptr, F.SSQ2()};
        pg8::gemm_phase<pg8::EpiRes<false>, pg8::StaticOrder, true, true>(F.lds, g, S, E);
#pragma unroll 1
        for (int t = F.bid; t < 16 * 16; t += F.G) rgemm_tile<2, 4, FF / 8, 3>(F, F.U(), F.Wdt(), M_PROMPT + 32 * (t >> 4), 64 * (t & 15), 32, t & 15);
    } SEAM(6);
    if (IN(7)) { PHASE_BEGIN(); final_norm(F); }
#undef IN
#undef SEAM
}
extern "C" void kernel_launch(void* const* d_in, const int* in_sizes, int n_in, void* d_out, int out_size, void* d_ws, size_t ws_size, hipStream_t stream) {
    static int grid = 0;
    if (grid == 0) {
        if (n_in != 26 || out_size != (int)O_END || ws_size < WS_END) { fprintf(stderr, "kernel_launch: unexpected shapes (n_in %d, out %d, ws %zu)\n", n_in, out_size, ws_size); grid = -1; return; }
        int dev = 0, cus = 0, per_cu = 0;
        if (hipGetDevice(&dev) != hipSuccess || hipDeviceGetAttribute(&cus, hipDeviceAttributeMultiprocessorCount, dev) != hipSuccess) { grid = -1; return; }
        if (hipOccupancyMaxActiveBlocksPerMultiprocessor(&per_cu, (const void*)hymba_fwd, NWAVES * 64, 0) != hipSuccess || per_cu < 1) { fprintf(stderr, "kernel_launch: occupancy query says %d blocks per CU\n", per_cu); (void)hipGetLastError(); grid = -1; return; }
        grid = cus;
    }
    if (grid < 0) return;
    if (hipMemsetAsync((char*)d_ws + WS_CTL, 0, CTL_ZERO_BYTES, stream) != hipSuccess) return;
    Args a{};
    for (int i = 0; i < 26; ++i) a.in[i] = (const float*)d_in[i];
    a.out = (float*)d_out; a.ws = (unsigned char*)d_ws;
    hipLaunchKernelGGL(hymba_fwd, dim3(grid), dim3(NWAVES * 64), 0, stream, a);
}
```
